# Optimizing an MI355X kernel written in HIP

```python
import math
import jax, jax.numpy as jnp
from jax import lax
import numpy as np

D_MODEL = 1024
BATCH = 4
SEQ = 8192
DEPTH = 1

MIX_WIDTH = D_MODEL
POOL_WIDTH = MIX_WIDTH // 2
POOL_WINDOWS = (2, 4, 8, 16)
N_POOL_GROUPS = len(POOL_WINDOWS)
POOL_GROUP_DIM = POOL_WIDTH // N_POOL_GROUPS
ATTN_WIDTH = MIX_WIDTH - POOL_WIDTH
HEAD_DIM = 64
N_HEADS = ATTN_WIDTH // HEAD_DIM
DILATED_PATTERNS = ((128, 1), (512, 4), (2048, 16))
BLOCK = 128
N_BUCKETS = 32
MAX_DISTANCE = 2048
D_FF = 4 * D_MODEL
NORM_EPS = 1e-6
NEG_INF = -1e30

kernel_name = "hybrid_pool_dilated_attn_layer"


def rms_norm(x, g):
    xf = x.astype(jnp.float32)
    y = xf * lax.rsqrt(jnp.mean(xf * xf, axis=-1, keepdims=True) + NORM_EPS)
    return (y * g.astype(jnp.float32)).astype(x.dtype)


def t5_bucket(dist):
    max_exact = N_BUCKETS // 2
    d_f = jnp.maximum(dist, 1).astype(jnp.float32)
    large = max_exact + (jnp.log(d_f / max_exact) / math.log(MAX_DISTANCE / max_exact)
                         * (N_BUCKETS - max_exact)).astype(jnp.int32)
    large = jnp.minimum(large, N_BUCKETS - 1)
    return jnp.where(dist < max_exact, dist, large)


def causal_mean_minus_self(u, window):
    uf = u.astype(jnp.float32)
    s = uf.shape[1]
    c = jnp.pad(jnp.cumsum(uf, axis=1), ((0, 0), (window, 0), (0, 0)))
    window_sum = c[:, window:] - c[:, :s]
    count = jnp.minimum(jnp.arange(1, s + 1), window).astype(jnp.float32)
    return window_sum / count[None, :, None] - uf


def multiscale_pool_mixer(u, pool_w, pool_scale):
    b, s, _ = u.shape
    ug = u.reshape(b, s, N_POOL_GROUPS, POOL_GROUP_DIM)
    pooled = jnp.stack([causal_mean_minus_self(ug[:, :, g], w)
                        for g, w in enumerate(POOL_WINDOWS)], axis=2)
    mixed = jnp.einsum('bsgc,gcd->bsgd', pooled.astype(u.dtype), pool_w)
    mixed = mixed * pool_scale.reshape(N_POOL_GROUPS, POOL_GROUP_DIM)
    return mixed.reshape(b, s, POOL_WIDTH).astype(u.dtype)


def dilated_window_attention(q, k, v, rel_bias, window, dilation):
    b, h, s, d = q.shape
    w = window // dilation
    assert w <= BLOCK
    L = s // dilation
    nb = -(-L // BLOCK)
    Lp = nb * BLOCK

    def to_blocks(t):
        t = t.reshape(b, h, L, dilation, d).transpose(0, 1, 3, 2, 4)
        t = jnp.pad(t, ((0, 0), (0, 0), (0, 0), (0, Lp - L), (0, 0)))
        return t.reshape(b, h, dilation, nb, BLOCK, d)

    def with_prev(t):
        prev = jnp.pad(t[:, :, :, :-1], ((0, 0), (0, 0), (0, 0), (1, 0), (0, 0), (0, 0)))
        return jnp.concatenate([prev, t], axis=-2)

    qb = to_blocks(q)
    kb = with_prev(to_blocks(k))
    vb = with_prev(to_blocks(v))

    qq = jnp.arange(BLOCK)[:, None]
    kk = jnp.arange(2 * BLOCK)[None, :]
    dist = qq + BLOCK - kk
    rel_ok = (dist >= 0) & (dist <= w)
    mask = rel_ok[None] & ((jnp.arange(nb)[:, None, None] > 0) | (kk >= BLOCK)[None])
    bucket = t5_bucket(jnp.clip(dist, 0, w) * dilation)
    bias = rel_bias[bucket].astype(jnp.float32).transpose(2, 0, 1)

    scores = jnp.einsum('bhrnqd,bhrnkd->bhrnqk', qb, kb,
                        preferred_element_type=jnp.float32)
    scores = jnp.where(mask[None, None, None], scores + bias[None, :, None, None], NEG_INF)
    m = jnp.max(scores, axis=-1, keepdims=True)
    p = jnp.exp(scores - m)
    l = jnp.sum(p, axis=-1, keepdims=True)
    acc = jnp.einsum('bhrnqk,bhrnkd->bhrnqd', p.astype(v.dtype), vb,
                     preferred_element_type=jnp.float32)

    def from_blocks(t):
        e = t.shape[-1]
        t = t.reshape(b, h, dilation, Lp, e)[:, :, :, :L]
        return t.transpose(0, 1, 3, 2, 4).reshape(b, h, s, e)

    return from_blocks(acc), from_blocks(m), from_blocks(l)


def dilated_attention_mixer(q, k, v, q_norm_g, k_norm_g, rel_bias):
    b, s, _ = q.shape
    split = lambda t: t.reshape(b, s, N_HEADS, HEAD_DIM).transpose(0, 2, 1, 3)
    qh = rms_norm(split(q), q_norm_g) * (HEAD_DIM ** -0.5)
    kh = rms_norm(split(k), k_norm_g)
    vh = split(v)
    outs = [dilated_window_attention(qh, kh, vh, rel_bias, w, dl)
            for (w, dl) in DILATED_PATTERNS]
    m_all = jnp.max(jnp.stack([o[1] for o in outs]), axis=0)
    num = sum(jnp.exp(mi - m_all) * acc for acc, mi, _ in outs)
    den = sum(jnp.exp(mi - m_all) * li for _, mi, li in outs)
    o = (num / den).astype(q.dtype)
    return o.transpose(0, 2, 1, 3).reshape(b, s, ATTN_WIDTH)


def setup_inputs(seed: int = 0) -> dict:
    key = jax.random.key(seed)
    ks = jax.random.split(key, 12)
    f32 = jnp.float32
    nrm = lambda k, shape, scale: jax.random.normal(k, shape, f32) * scale
    return {
        "x": nrm(ks[0], (BATCH, SEQ, D_MODEL), 1.0),
        "mix_norm_g": 1.0 + nrm(ks[1], (D_MODEL,), 0.02),
        "w_in": nrm(ks[2], (D_MODEL, POOL_WIDTH + 3 * ATTN_WIDTH), D_MODEL ** -0.5),
        "pool_w": nrm(ks[3], (N_POOL_GROUPS, POOL_GROUP_DIM, POOL_GROUP_DIM), POOL_GROUP_DIM ** -0.5),
        "pool_scale": 1.0 + nrm(ks[4], (POOL_WIDTH,), 0.02),
        "q_norm_g": 1.0 + nrm(ks[5], (HEAD_DIM,), 0.02),
        "k_norm_g": 1.0 + nrm(ks[6], (HEAD_DIM,), 0.02),
        "rel_bias": nrm(ks[7], (N_BUCKETS, N_HEADS), 0.1),
        "w_out": nrm(ks[8], (MIX_WIDTH, D_MODEL), MIX_WIDTH ** -0.5),
        "mlp_norm_g": 1.0 + nrm(ks[9], (D_MODEL,), 0.02),
        "w_up": nrm(ks[10], (D_MODEL, D_FF), D_MODEL ** -0.5),
        "w_down": nrm(ks[11], (D_FF, D_MODEL), D_FF ** -0.5),
    }


def reference(x, mix_norm_g, w_in, pool_w, pool_scale, q_norm_g, k_norm_g, rel_bias,
              w_out, mlp_norm_g, w_up, w_down):
    h = x
    for _ in range(DEPTH):
        a = rms_norm(h, mix_norm_g)
        proj = jnp.einsum('bsd,de->bse', a, w_in)
        u_pool = proj[..., :POOL_WIDTH]
        q = proj[..., POOL_WIDTH:POOL_WIDTH + ATTN_WIDTH]
        k = proj[..., POOL_WIDTH + ATTN_WIDTH:POOL_WIDTH + 2 * ATTN_WIDTH]
        v = proj[..., POOL_WIDTH + 2 * ATTN_WIDTH:]
        y_pool = multiscale_pool_mixer(u_pool, pool_w, pool_scale)
        y_attn = dilated_attention_mixer(q, k, v, q_norm_g, k_norm_g, rel_bias)
        mixed = jnp.concatenate([y_pool, y_attn], axis=-1)
        h = h + jnp.einsum('bse,ed->bsd', mixed, w_out)
        c = rms_norm(h, mlp_norm_g)
        ff = jnp.square(jax.nn.relu(jnp.einsum('bsd,df->bsf', c, w_up)))
        h = h + jnp.einsum('bsf,fd->bsd', ff, w_down)
    return h
```

```cpp
#include <hip/hip_runtime.h>
#include <cstdio>
#include <cstdint>
namespace pg8 {
#define PG8_LAS __attribute__((address_space(3)))
typedef unsigned short bf16_t;
typedef short bf16x8 __attribute__((ext_vector_type(8)));
typedef float f32x4 __attribute__((ext_vector_type(4)));
typedef unsigned u32x4 __attribute__((ext_vector_type(4)));
constexpr int BM = 256, BK = 64, HALF = 128, HTB = HALF * BK * 2  , STAGE_BYTES = 8 * HTB, NXCD = 8, WGM = 8;

__host__ __device__ __forceinline__ int lds_byte(int r, int c) { const int st = (r >> 4) * 2 + (c >> 5), rr = r & 15, cc = c & 31, ob = rr * 64 + cc * 2; return st * 1024 + (ob ^ (((ob >> 9) & 1) << 5)); }
__host__ __device__ __forceinline__ void stage_rc(int b, int& R, int& C) { const int st = b / 1024, sb = b % 1024, swz = sb ^ (((sb >> 9) & 1) << 5); R = (st >> 1) * 16 + swz / 64; C = (st & 1) * 32 + (swz % 64) / 2; }
__host__ __device__ __forceinline__ int perm32(int rho) { const int n = rho >> 4, i = rho & 15; return 8 * (i >> 2) + 4 * n + (i & 3); }

struct Unit { int pm, pn; };
struct Gemm { const bf16_t* A; const bf16_t* Bt; int M, N, K; };

struct StaticOrder {
    int nM, nN, nwg, G, c;
    __host__ __device__ void init(int M, int N, int G_, int c_) { nM = M / BM; nN = N / BM; nwg = nM * nN; G = G_; c = c_; }
    __host__ __device__ bool next(int i, Unit& u) const {
        const long L = (long)i * G + c; if (L >= nwg) return false;
        int wgid = (int)L; { const int q = nwg / NXCD, r = nwg % NXCD, xcd = wgid % NXCD, off = wgid / NXCD; wgid = (xcd < r ? xcd * (q + 1) : r * (q + 1) + (xcd - r) * q) + off; }
        const int nig = WGM * nN, gid = wgid / nig, fm = gid * WGM, gsz = (nM - fm) < WGM ? (nM - fm) : WGM;
        u.pm = fm + ((wgid % nig) % gsz); u.pn = (wgid % nig) / gsz; return true;
    }
    __device__ __forceinline__ void a_ready(const Unit&) const {}
    __device__ __forceinline__ void done(const Unit&) const {}
};

__device__ __forceinline__ unsigned cvt_pk_bf16(float lo, float hi) { unsigned r; asm volatile("v_cvt_pk_bf16_f32 %0, %1, %2" : "=v"(r) : "v"(lo), "v"(hi)); return r; }
typedef float f32x2 __attribute__((ext_vector_type(2)));
template <class Epi, class Sched, bool ALIGN_EPI = false, bool SP2 = false>
__device__ __forceinline__ void gemm_phase(PG8_LAS unsigned char* lds, const Gemm g, const Sched& S, const Epi& E) {
    const int tid = threadIdx.x, wid = __builtin_amdgcn_readfirstlane(tid >> 6), lane = tid & 63, wr = wid >> 2, wc = wid & 3, fr = lane & 15, fq = lane >> 4;
    const int K = g.K, nt = K / BK;
    unsigned voffA[2], voffB[2];
#pragma unroll
    for (int i = 0; i < 2; ++i) { int R, C; stage_rc(tid * 16 + i * 8192, R, C); const int Rb = Epi::PERM ? ((R & ~31) + perm32(R & 31)) : R;
        voffA[i] = (unsigned)(R * K + C) * 2u; voffB[i] = (unsigned)(Rb * K + C) * 2u; }
    const size_t kstep = (size_t)(BK * 2);
    const size_t hstep = (size_t)HALF * K * 2;
    const size_t tstep = 2 * hstep;
    const unsigned ldsw = (unsigned)wid * 1024u;
    const int aoff = lds_byte(wr * 64 + fr, fq * 8), boff = lds_byte(wc * 32 + fr, fq * 8);
#define PG8_SA(b, h) (((b) * 2 + (h)) * HTB)
#define PG8_SB(b, h) ((4 + (b) * 2 + (h)) * HTB)
#define PG8_STAGE(bufoff, gbase, voff) do { _Pragma("unroll") for (int _i = 0; _i < 2; ++_i) \
        __builtin_amdgcn_global_load_lds((const unsigned*)((const char*)(gbase) + (voff)[_i]), (PG8_LAS unsigned*)(lds + (bufoff) + ldsw + _i * 8192), 16, 0, 0); } while (0)
#define PG8_LDA(dst, b, h) do { _Pragma("unroll") for (int m = 0; m < 4; ++m) _Pragma("unroll") for (int k = 0; k < 2; ++k) dst[m][k] = *(const PG8_LAS bf16x8*)(lds + PG8_SA(b, h) + aoff + m * 2048 + k * 1024); } while (0)
#define PG8_LDB(dst, b, h) do { _Pragma("unroll") for (int n = 0; n < 2; ++n) _Pragma("unroll") for (int k = 0; k < 2; ++k) dst[n][k] = *(const PG8_LAS bf16x8*)(lds + PG8_SB(b, h) + boff + n * 2048 + k * 1024); } while (0)
#define PG8_MMA(ai, bj, At, Bt) do { __builtin_amdgcn_s_setprio(1); _Pragma("unroll") for (int m = 0; m < 4; ++m) _Pragma("unroll") for (int n = 0; n < 2; ++n) _Pragma("unroll") for (int k = 0; k < 2; ++k) \
        acc[ai][bj][m][n] = __builtin_amdgcn_mfma_f32_16x16x32_bf16(Bt[n][k], At[m][k], acc[ai][bj][m][n], 0, 0, 0); __builtin_amdgcn_s_setprio(0); } while (0)
#define PG8_WAIT_V(n) asm volatile("s_waitcnt vmcnt(" #n ")" ::: "memory")
#define PG8_WAIT_L(n) asm volatile("s_waitcnt lgkmcnt(" #n ")" ::: "memory")
#define PG8_BAR __builtin_amdgcn_s_barrier()
#define PG8_SCHED __builtin_amdgcn_sched_barrier(0)
    Unit cur, nxt; int ui = 0;
    if (!S.next(0, cur)) return;
    f32x4 acc[2][2][4][2];
#pragma unroll
    for (int a = 0; a < 2; ++a)
#pragma unroll
        for (int b = 0; b < 2; ++b)
#pragma unroll
            for (int m = 0; m < 4; ++m)
#pragma unroll
                for (int n = 0; n < 2; ++n) acc[a][b][m][n] = (f32x4){0.f, 0.f, 0.f, 0.f};
    bf16x8 At[4][2], B0[2][2], B1[2][2];
    const char* cA = (const char*)g.A + (size_t)cur.pm * tstep; const char* cB = (const char*)g.Bt + (size_t)cur.pn * tstep;
    S.a_ready(cur);
    if constexpr (SP2) {
        PG8_STAGE(PG8_SB(0, 0), cB, voffB); PG8_STAGE(PG8_SB(0, 1), cB + hstep, voffB); PG8_STAGE(PG8_SA(0, 0), cA, voffA); PG8_STAGE(PG8_SA(0, 1), cA + hstep, voffA);
        if (wr == 1) PG8_BAR;
        PG8_WAIT_V(2); PG8_BAR;
        PG8_STAGE(PG8_SB(1, 0), cB + kstep, voffB); PG8_STAGE(PG8_SA(1, 0), cA + kstep, voffA); PG8_STAGE(PG8_SB(1, 1), cB + hstep + kstep, voffB);
        PG8_WAIT_V(6); PG8_BAR;
    } else {
        PG8_STAGE(PG8_SB(0, 0), cB, voffB); PG8_STAGE(PG8_SA(0, 0), cA, voffA); PG8_STAGE(PG8_SB(0, 1), cB + hstep, voffB); PG8_STAGE(PG8_SA(0, 1), cA + hstep, voffA);
        if (wr == 1) PG8_BAR;
        PG8_WAIT_V(4); PG8_BAR;
        PG8_STAGE(PG8_SB(1, 0), cB + kstep, voffB); PG8_STAGE(PG8_SA(1, 0), cA + kstep, voffA); PG8_STAGE(PG8_SB(1, 1), cB + hstep + kstep, voffB);
        PG8_WAIT_V(6); PG8_BAR;
    }
    for (;;) {
        const bool has_next = S.next(ui + 1, nxt);
        const char* nA = has_next ? (const char*)g.A + (size_t)nxt.pm * tstep : cA; const char* nB = has_next ? (const char*)g.Bt + (size_t)nxt.pn * tstep : cB;
        for (int t = 0; t < nt; t += 2) {
            const bool last = (t == nt - 2);
            const char* a1 = cA + (size_t)(t + 1) * kstep;
            const char* a2 = last ? nA : cA + (size_t)(t + 2) * kstep; const char* b2 = last ? nB : cB + (size_t)(t + 2) * kstep;
            const char* a3 = a2 + kstep; const char* b3 = b2 + kstep;
            if (last && has_next) S.a_ready(nxt);
            if constexpr (SP2) {
            PG8_LDB(B0, 0, 0); PG8_LDB(B1, 0, 1); PG8_SCHED; PG8_LDA(At, 0, 0); PG8_STAGE(PG8_SA(1, 1), a1 + hstep, voffA);
            PG8_WAIT_V(8); PG8_WAIT_L(0); PG8_BAR; PG8_MMA(0, 0, At, B0); PG8_MMA(0, 1, At, B1); PG8_BAR; PG8_SCHED;
            PG8_LDA(At, 0, 1); PG8_STAGE(PG8_SB(0, 0), b2, voffB); PG8_STAGE(PG8_SB(0, 1), b2 + hstep, voffB); PG8_STAGE(PG8_SA(0, 0), a2, voffA);
            PG8_WAIT_V(8); PG8_WAIT_L(0); PG8_BAR; PG8_MMA(1, 0, At, B0); PG8_MMA(1, 1, At, B1); PG8_BAR; PG8_SCHED;
            PG8_LDB(B0, 1, 0); PG8_LDB(B1, 1, 1); PG8_SCHED; PG8_LDA(At, 1, 0); PG8_STAGE(PG8_SA(0, 1), a2 + hstep, voffA);
            PG8_WAIT_V(8); PG8_WAIT_L(0); PG8_BAR; PG8_MMA(0, 0, At, B0); PG8_MMA(0, 1, At, B1); PG8_BAR; PG8_SCHED;
            PG8_LDA(At, 1, 1); PG8_STAGE(PG8_SB(1, 0), b3, voffB); PG8_STAGE(PG8_SB(1, 1), b3 + hstep, voffB); PG8_STAGE(PG8_SA(1, 0), a3, voffA);
            PG8_WAIT_V(8); PG8_WAIT_L(0); PG8_BAR; PG8_MMA(1, 0, At, B0); PG8_MMA(1, 1, At, B1); PG8_BAR; PG8_SCHED;
            } else {
            PG8_LDB(B0, 0, 0); PG8_SCHED; PG8_LDA(At, 0, 0); PG8_STAGE(PG8_SA(1, 1), a1 + hstep, voffA);
            PG8_WAIT_L(8); PG8_BAR; PG8_WAIT_L(0); PG8_MMA(0, 0, At, B0); PG8_BAR; PG8_SCHED;
            PG8_LDB(B1, 0, 1); PG8_STAGE(PG8_SB(0, 0), b2, voffB);
            PG8_BAR; PG8_WAIT_L(0); PG8_MMA(0, 1, At, B1); PG8_BAR;
            PG8_LDA(At, 0, 1); PG8_STAGE(PG8_SA(0, 0), a2, voffA);
            PG8_BAR; PG8_WAIT_L(0); PG8_MMA(1, 0, At, B0); PG8_BAR; PG8_SCHED;
            PG8_STAGE(PG8_SB(0, 1), b2 + hstep, voffB);
            PG8_WAIT_V(6); PG8_BAR; PG8_MMA(1, 1, At, B1); PG8_BAR;
            PG8_LDB(B0, 1, 0); PG8_SCHED; PG8_LDA(At, 1, 0); PG8_STAGE(PG8_SA(0, 1), a2 + hstep, voffA);
            PG8_WAIT_L(8); PG8_BAR; PG8_WAIT_L(0); PG8_MMA(0, 0, At, B0); PG8_BAR; PG8_SCHED;
            PG8_LDB(B1, 1, 1); PG8_STAGE(PG8_SB(1, 0), b3, voffB);
            PG8_BAR; PG8_WAIT_L(0); PG8_MMA(0, 1, At, B1); PG8_BAR;
            PG8_LDA(At, 1, 1); PG8_STAGE(PG8_SA(1, 0), a3, voffA);
            PG8_BAR; PG8_WAIT_L(0); PG8_MMA(1, 0, At, B0); PG8_BAR; PG8_SCHED;
            PG8_STAGE(PG8_SB(1, 1), b3 + hstep, voffB);
            PG8_WAIT_V(6); PG8_BAR; PG8_MMA(1, 1, At, B1); PG8_BAR;
            }
        }
        if constexpr (ALIGN_EPI) { if (wr == 0) PG8_BAR; }
        if constexpr (!Epi::AFTER_DRAIN) { E(acc, cur, wr, wc, fr, fq); S.done(cur); }
        if (!has_next) break;
#pragma unroll
        for (int a = 0; a < 2; ++a)
#pragma unroll
            for (int b = 0; b < 2; ++b)
#pragma unroll
                for (int m = 0; m < 4; ++m)
#pragma unroll
                    for (int n = 0; n < 2; ++n) acc[a][b][m][n] = (f32x4){0.f, 0.f, 0.f, 0.f};
        cur = nxt; cA = nA; cB = nB; ++ui;
        if constexpr (ALIGN_EPI) { if (wr == 1) PG8_BAR; }
    }
    PG8_WAIT_V(0);
    if constexpr (!ALIGN_EPI) { if (wr == 0) PG8_BAR; }
    PG8_BAR;
    if constexpr (Epi::AFTER_DRAIN) { E.fused(acc, cur, wr, wc, fr, fq, lds, wid, lane); S.done(cur); }
#undef PG8_SA
#undef PG8_SB
#undef PG8_STAGE
#undef PG8_LDA
#undef PG8_LDB
#undef PG8_MMA
#undef PG8_WAIT_V
#undef PG8_WAIT_L
#undef PG8_BAR
#undef PG8_SCHED
}
}
namespace pg8 {
constexpr float NORM_EPS_F = 1e-6f;
constexpr float C2 = 0.125f * 1.4426950408889634f;
__device__ __forceinline__ float hsum4(const f32x4 v) { return (v[0] + v[1]) + (v[2] + v[3]); }
__device__ __forceinline__ float hsq4(const f32x4 v) { return (v[0] * v[0] + v[1] * v[1]) + (v[2] * v[2] + v[3] * v[3]); }
__device__ __forceinline__ u32x4 pack8(const f32x4 a, const f32x4 b) { u32x4 w; w.x = cvt_pk_bf16(a[0], a[1]); w.y = cvt_pk_bf16(a[2], a[3]); w.z = cvt_pk_bf16(b[0], b[1]); w.w = cvt_pk_bf16(b[2], b[3]); return w; }

struct EpiInProj {
    static constexpr bool PERM = true, AFTER_DRAIN = false;
    bf16_t *U, *Q, *K, *V; const float *qg, *kg;
    __device__ __forceinline__ void operator()(const f32x4 (&acc)[2][2][4][2], const Unit& u, int wr, int wc, int fr, int fq) const {
        const int row0 = u.pm * BM + wr * 64 + fr;
        const int kind = u.pn >> 1;
        if (kind == 0) {
            const int col0 = (u.pn & 1) * 256 + 64 * wc + 8 * fq;
#pragma unroll
            for (int ai = 0; ai < 2; ++ai)
#pragma unroll
                for (int m = 0; m < 4; ++m) { bf16_t* rowp = U + (size_t)(row0 + ai * HALF + m * 16) * 512 + col0;
#pragma unroll
                    for (int bj = 0; bj < 2; ++bj) *(u32x4*)(rowp + 32 * bj) = pack8(acc[ai][bj][m][0], acc[ai][bj][m][1]); }
        } else {
            const int head = 4 * (u.pn & 1) + wc;
            bf16_t* dst = kind == 1 ? Q : (kind == 2 ? K : V);
            const float* g = kind == 1 ? qg : kg;
            const float gs = kind == 1 ? C2 : 1.0f;
            f32x4 gv[2][2];
#pragma unroll
            for (int bj = 0; bj < 2; ++bj)
#pragma unroll
                for (int n = 0; n < 2; ++n) gv[bj][n] = (kind == 3) ? (f32x4){1.f, 1.f, 1.f, 1.f} : *(const f32x4*)(g + 32 * bj + 8 * fq + 4 * n) * gs;
#pragma unroll
            for (int ai = 0; ai < 2; ++ai)
#pragma unroll
                for (int m = 0; m < 4; ++m) {
                    const int row = row0 + ai * HALF + m * 16, b = row >> 13, t = row & 8191;
                    bf16_t* rowp = dst + ((size_t)(b * 8 + head) * 8192 + t) * 64 + 8 * fq;
                    float ss = (hsq4(acc[ai][0][m][0]) + hsq4(acc[ai][0][m][1])) + (hsq4(acc[ai][1][m][0]) + hsq4(acc[ai][1][m][1]));
                    ss += __shfl_xor(ss, 16); ss += __shfl_xor(ss, 32);
                    const float r = (kind == 3) ? 1.0f : __builtin_amdgcn_rsqf(ss * (1.0f / 64.0f) + NORM_EPS_F);
#pragma unroll
                    for (int bj = 0; bj < 2; ++bj) *(u32x4*)(rowp + 32 * bj) = pack8(acc[ai][bj][m][0] * gv[bj][0] * r, acc[ai][bj][m][1] * gv[bj][1] * r);
                }
        }
    }
};
struct EpiOut {
    static constexpr bool PERM = true, AFTER_DRAIN = false;
    const float* x; float* hout; bf16_t* HB; float* RSS;
    __device__ __forceinline__ void operator()(const f32x4 (&acc)[2][2][4][2], const Unit& u, int wr, int wc, int fr, int fq) const {
        const int row0 = u.pm * BM + wr * 64 + fr, col0 = u.pn * BM + wc * 32 + 8 * fq;
#pragma unroll
        for (int ai = 0; ai < 2; ++ai)
#pragma unroll
            for (int m = 0; m < 4; ++m) {
                const int row = row0 + ai * HALF + m * 16; const size_t off = (size_t)row * 1024 + col0; float ss = 0.f;
#pragma unroll
                for (int bj = 0; bj < 2; ++bj) {
                    const f32x4 h0 = *(const f32x4*)(x + off + bj * HALF) + acc[ai][bj][m][0], h1 = *(const f32x4*)(x + off + bj * HALF + 4) + acc[ai][bj][m][1];
                    *(f32x4*)(hout + off + bj * HALF) = h0; *(f32x4*)(hout + off + bj * HALF + 4) = h1;
                    ss += hsq4(h0) + hsq4(h1);
                    *(u32x4*)(HB + off + bj * HALF) = pack8(h0, h1);
                }
                ss += __shfl_xor(ss, 16); ss += __shfl_xor(ss, 32);
                if (fq == 0) RSS[(size_t)row * 16 + u.pn * 4 + wc] = ss;
            }
    }
};
struct EpiUp {
    static constexpr bool PERM = true, AFTER_DRAIN = false;
    const float* RSS; bf16_t* FF;
    __device__ __forceinline__ void operator()(const f32x4 (&acc)[2][2][4][2], const Unit& u, int wr, int wc, int fr, int fq) const {
        const int row0 = u.pm * BM + wr * 64 + fr, col0 = u.pn * BM + wc * 32 + 8 * fq;
#pragma unroll
        for (int ai = 0; ai < 2; ++ai)
#pragma unroll
            for (int m = 0; m < 4; ++m) {
                const int row = row0 + ai * HALF + m * 16;
                float s = hsum4(*(const f32x4*)(RSS + (size_t)row * 16 + 4 * fq));
                s += __shfl_xor(s, 16); s += __shfl_xor(s, 32);
                const float r = __builtin_amdgcn_rsqf(s * (1.0f / 1024.0f) + NORM_EPS_F);
                bf16_t* rowp = FF + (size_t)row * 4096 + col0;
#pragma unroll
                for (int bj = 0; bj < 2; ++bj) {
                    f32x4 v0 = acc[ai][bj][m][0] * r, v1 = acc[ai][bj][m][1] * r;
#pragma unroll
                    for (int e = 0; e < 4; ++e) { v0[e] = __builtin_fmaxf(v0[e], 0.f); v1[e] = __builtin_fmaxf(v1[e], 0.f); }
                    *(u32x4*)(rowp + bj * HALF) = pack8(v0 * v0, v1 * v1);
                }
            }
    }
};
struct EpiDown {
    static constexpr bool PERM = true, AFTER_DRAIN = false;
    float* out;
    __device__ __forceinline__ void operator()(const f32x4 (&acc)[2][2][4][2], const Unit& u, int wr, int wc, int fr, int fq) const {
        const int row0 = u.pm * BM + wr * 64 + fr, col0 = u.pn * BM + wc * 32 + 8 * fq;
#pragma unroll
        for (int ai = 0; ai < 2; ++ai)
#pragma unroll
            for (int m = 0; m < 4; ++m) { float* rowp = out + (size_t)(row0 + ai * HALF + m * 16) * 1024 + col0;
#pragma unroll
                for (int bj = 0; bj < 2; ++bj)
#pragma unroll
                    for (int n = 0; n < 2; ++n) { float* p = rowp + bj * HALF + 4 * n; *(f32x4*)p = *(const f32x4*)p + acc[ai][bj][m][n]; } }
    }
};
}
#include <cmath>
#define GAS __attribute__((address_space(1)))
#define LAS __attribute__((address_space(3)))
typedef unsigned short bf16;
typedef unsigned v4u __attribute__((ext_vector_type(4)));
typedef float f32x4 __attribute__((ext_vector_type(4)));
typedef short bf16x8 __attribute__((ext_vector_type(8)));
typedef GAS unsigned gu32;
typedef GAS unsigned long long gu64;
#define RLX_AGENT __ATOMIC_RELAXED, __HIP_MEMORY_SCOPE_AGENT
#define LDS_WAIT() asm volatile("s_waitcnt lgkmcnt(0)" ::: "memory")
#define VM_WAIT() asm volatile("s_waitcnt vmcnt(0)" ::: "memory")
__device__ __forceinline__ unsigned long long rt() { return __builtin_amdgcn_s_memrealtime(); }
__device__ __forceinline__ unsigned f2bf(float f) { unsigned u = __builtin_bit_cast(unsigned, f); return (u + 0x7fffu + ((u >> 16) & 1u)) >> 16; }
__device__ __forceinline__ unsigned pk2(float lo, float hi) { return f2bf(lo) | (f2bf(hi) << 16); }

#define XB_TMO      128
#define XB_XCNT(j)  (256  + 64 * (j))
#define XB_XSUB(j)  (1280 + 64 * (j))
#define XB_XGEN(j)  (2304 + 64 * (j))
#define XB_TOP      3328
#define XB_TOPGEN   3392
#define XCD_BAR_WORDS 3456
#define XB_SPIN_CAP (1u << 18)

__device__ __forceinline__ unsigned xb_ld(unsigned* p)              { return __hip_atomic_load(p, __ATOMIC_RELAXED, __HIP_MEMORY_SCOPE_AGENT); }
__device__ __forceinline__ unsigned xb_add(unsigned* p, unsigned v) { return __hip_atomic_fetch_add(p, v, __ATOMIC_RELAXED, __HIP_MEMORY_SCOPE_AGENT); }
__device__ __forceinline__ unsigned xb_xcc_id() { return (unsigned)__builtin_amdgcn_s_getreg((3 << 11) | 20) & 0xFu; }
#define XB_SPIN(cond, bar) do { unsigned _sp = 0; while (cond) { __builtin_amdgcn_s_sleep(1); \
    if ((++_sp & 255u) == 0u) { if (xb_ld(&(bar)[XB_TMO])) break; if (_sp > XB_SPIN_CAP) { atomicAdd(&(bar)[XB_TMO], 1u); break; } } } } while (0)

struct XcdBarrier {
    unsigned* bar; unsigned x;
    volatile LAS unsigned* st;
};

__device__ __forceinline__ XcdBarrier xcd_barrier_post(unsigned* bar, volatile LAS unsigned* st) {
    XcdBarrier b; b.bar = bar; b.x = xb_xcc_id(); b.st = st;
    if (threadIdx.x == 0) (void)xb_add(&bar[XB_XCNT(b.x)], 1u);
    return b;
}
__device__ __forceinline__ void xcd_barrier_complete(unsigned* bar, unsigned x, unsigned& nloc, unsigned& nx) {
    const unsigned G = gridDim.x * gridDim.y * gridDim.z;
    unsigned sum, cnt, mine, sp = 0u;
    for (;;) {
        sum = 0u; cnt = 0u; mine = 0u;
#pragma unroll
        for (unsigned j = 0; j < 16; ++j) { const unsigned c = xb_ld(&bar[XB_XCNT(j)]); sum += c; cnt += (c > 0u) ? 1u : 0u; mine = (j == x) ? c : mine; }
        if (sum == G) break;
        __builtin_amdgcn_s_sleep(1);
        if ((++sp & 255u) == 0u) { if (xb_ld(&bar[XB_TMO])) break; if (sp > XB_SPIN_CAP) { atomicAdd(&bar[XB_TMO], 1u); break; } }
    }
    nloc = mine > 0u ? mine : 1u; nx = cnt > 0u ? cnt : 1u;
}

__device__ __forceinline__ void xcd_barrier(const XcdBarrier& b) {
    asm volatile("s_waitcnt vmcnt(0)" ::: "memory");
    __syncthreads();
    if (threadIdx.x == 0) {
        unsigned* bar = b.bar;
        __builtin_amdgcn_s_waitcnt(0);
        unsigned nloc = b.st[0], nx = b.st[1];
        if (nloc == 0u) { xcd_barrier_complete(bar, b.x, nloc, nx); b.st[0] = nloc; b.st[1] = nx; }
        const unsigned old = xb_add(&bar[XB_XSUB(b.x)], 1u);
        const unsigned gen = old / nloc;
        if (old + 1u == (gen + 1u) * nloc) {
            __builtin_amdgcn_fence(__ATOMIC_RELEASE, "agent");
            asm volatile("s_waitcnt vmcnt(0)" ::: "memory");
            const unsigned og = xb_add(&bar[XB_TOP], 1u);
            const unsigned tg = og / nx;
            if (og + 1u == (tg + 1u) * nx) xb_add(&bar[XB_TOPGEN], 1u);
            else XB_SPIN(xb_ld(&bar[XB_TOPGEN]) == tg, bar);
            __builtin_amdgcn_fence(__ATOMIC_ACQUIRE, "agent");
            xb_add(&bar[XB_XGEN(b.x)], 1u);
            asm volatile("s_waitcnt vmcnt(0)" ::: "memory");
        } else {
            XB_SPIN(xb_ld(&bar[XB_XGEN(b.x)]) == gen, bar);
            __builtin_amdgcn_fence(__ATOMIC_ACQUIRE, "agent");
            asm volatile("s_waitcnt vmcnt(0)" ::: "memory");
        }
    }
    __syncthreads();
}
constexpr int NWAVES = 8;
#ifndef MK_PER_PHASE
#define MK_PER_PHASE 0
#endif
constexpr int NPHASE = 6;

constexpr int BATCH = 4, T = 8192, D = 1024, NH = 8, HD = 64, FF = 4096, PW = 512, AW = 512;
constexpr int M = BATCH * T;
constexpr int NIN = PW + 3 * AW;
constexpr float NORM_EPS = 1e-6f;
constexpr float LOG2E = 1.4426950408889634f;

constexpr size_t MiB = 1u << 20;
constexpr size_t WS_CTL = 0, CTL_ZERO_BYTES = 1 * MiB;
constexpr size_t WS_WIN = 1 * MiB, WS_WOUT = 5 * MiB, WS_WUP = 7 * MiB, WS_WDN = 15 * MiB;
constexpr size_t WS_RSS = 23 * MiB;
constexpr size_t WS_PL = 25 * MiB;
constexpr size_t WS_HB = 28 * MiB;
constexpr size_t WS_FF = 92 * MiB;
constexpr size_t WS_XN = 92 * MiB, WS_U = 156 * MiB, WS_Q = 188 * MiB, WS_K = 220 * MiB, WS_V = 252 * MiB, WS_PO = 284 * MiB;
constexpr size_t WS_MIX = 348 * MiB;
constexpr size_t WS_END = 412 * MiB;
static_assert(WS_PO + 64 * MiB <= WS_FF + 256 * MiB && WS_MIX >= WS_FF + 256 * MiB && WS_HB + 64 * MiB <= WS_FF, "d_ws map");
constexpr int CW_BAR = 4096;

constexpr int RING_OFF = 0, RING_BYTES = 131072;
constexpr int LDSCTL_OFF = RING_BYTES, MISC_OFF = LDSCTL_OFF + 320;
constexpr int LDS_BYTES = 147456;

struct Frame {
    LAS unsigned char* lds;
    volatile LAS unsigned* MISC;
    gu32* ctl;
    int tid, lane, wave, vcu, G;
    const float *x, *g1, *w_in, *pool_w, *pool_s, *qg, *kg, *rel_bias, *w_out, *g2, *w_up, *w_dn;
    float* out;
    bf16 *Win_t, *Wout_t, *Wup_t, *Wdn_t;
    bf16 *XN, *U, *Q, *K, *V, *PO, *MIX, *HB, *FFB;
    float *RSS, *PL;
};

__device__ __forceinline__ float wave_sum(float v) {
#pragma unroll
    for (int o = 1; o < 64; o <<= 1) v += __shfl_xor(v, o);
    return v;
}
__device__ __forceinline__ float wave_max(float v) {
#pragma unroll
    for (int o = 1; o < 64; o <<= 1) v = __builtin_fmaxf(v, __shfl_xor(v, o));
    return v;
}
__device__ __forceinline__ float bf2f(unsigned short h) { return __builtin_bit_cast(float, (unsigned)h << 16); }
__device__ __forceinline__ float bflo(unsigned w) { return __builtin_bit_cast(float, w << 16); }
__device__ __forceinline__ float bfhi(unsigned w) { return __builtin_bit_cast(float, w & 0xffff0000u); }

__device__ __forceinline__ void p0_transpose_item(const float* W, int N, bf16* WT, int ldk, const float* gk, bool permute, LAS float* scr, int item, int lane) {
    const int nblk = N / 32, kb = item / nblk, nb = item % nblk, k0 = 64 * kb, n0 = 32 * nb;
#pragma unroll 8
    for (int i = 0; i < 32; ++i) { const int kk = 2 * i + (lane >> 5); float v = W[(size_t)(k0 + kk) * N + n0 + (lane & 31)]; if (gk) v *= gk[k0 + kk]; scr[kk * 33 + (lane & 31)] = v; }
    LDS_WAIT(); asm volatile("" ::: "memory");
    int rb = n0;
    if (permute) { const int pn = nb >> 3, w = nb & 7; rb = 256 * pn + 128 * (w & 1) + 32 * (w >> 1); }
    const int c = lane & 7;
#pragma unroll
    for (int j = 0; j < 4; ++j) { const int n = (lane >> 3) + 8 * j; const LAS float* s = scr + (8 * c) * 33 + n;
        v4u o; o.x = pk2(s[0 * 33], s[1 * 33]); o.y = pk2(s[2 * 33], s[3 * 33]); o.z = pk2(s[4 * 33], s[5 * 33]); o.w = pk2(s[6 * 33], s[7 * 33]);
        *(GAS v4u*)(WT + (size_t)(rb + n) * ldk + k0 + 8 * c) = o; }
    LDS_WAIT(); asm volatile("" ::: "memory");
}
__device__ __forceinline__ void p0_fold_item(const Frame& F, int item, int lane) {
    const int g = item >> 9, r = item & 511, c0 = 8 * (r >> 5) + 4 * (lane >> 5), n = 32 * (r & 31) + (lane & 31);
    const float* pw = F.pool_w + ((size_t)g * 128 + c0) * 128; const float* ps = F.pool_s + 128 * g; const float* wo = F.w_out + (size_t)(128 * g) * D + n;
    float a0 = 0.f, a1 = 0.f, a2 = 0.f, a3 = 0.f;
    for (int d = 0; d < 128; d += 4) {
        const f32x4 p0 = *(const f32x4*)(pw + d), p1 = *(const f32x4*)(pw + 128 + d), p2 = *(const f32x4*)(pw + 256 + d), p3 = *(const f32x4*)(pw + 384 + d), s4 = *(const f32x4*)(ps + d);
#pragma unroll
        for (int e = 0; e < 4; ++e) { const float w = s4[e] * wo[(size_t)(d + e) * D]; a0 += p0[e] * w; a1 += p1[e] * w; a2 += p2[e] * w; a3 += p3[e] * w; }
    }
    *(GAS unsigned long long*)(F.Wout_t + (size_t)n * D + 128 * g + c0) = (unsigned long long)pk2(a0, a1) | ((unsigned long long)pk2(a2, a3) << 32);
}
__device__ __forceinline__ void p0_prologue(Frame& F) {
    LAS float* scr = (LAS float*)(F.lds + RING_OFF + F.wave * 16384);
    const int gw = F.vcu * NWAVES + F.wave, NGW = F.G * NWAVES;
    constexpr int I_IN = (D / 64) * (NIN / 32), I_OUT = (512 / 64) * (D / 32), I_UP = (D / 64) * (FF / 32), I_DN = (FF / 64) * (D / 32), I_FOLD = 4 * 16 * 32;
    constexpr int NITEMS = I_IN + I_OUT + I_UP + I_DN + I_FOLD;
    for (int it = gw; it < NITEMS; it += NGW) {
        int r = it;
        if (r < I_FOLD) { p0_fold_item(F, r, F.lane); continue; } r -= I_FOLD;
        if (r < I_IN) { p0_transpose_item(F.w_in, NIN, F.Win_t, D, F.g1, true, scr, r, F.lane); continue; } r -= I_IN;
        if (r < I_OUT) { p0_transpose_item(F.w_out + (size_t)512 * D, D, F.Wout_t + 512, D, nullptr, false, scr, r, F.lane); continue; } r -= I_OUT;
        if (r < I_UP) { p0_transpose_item(F.w_up, FF, F.Wup_t, D, F.g2, false, scr, r, F.lane); continue; } r -= I_UP;
        p0_transpose_item(F.w_dn, D, F.Wdn_t, FF, nullptr, false, scr, r, F.lane);
    }
    f32x4 gq[4];
#pragma unroll
    for (int j = 0; j < 4; ++j) gq[j] = *(const f32x4*)(F.g1 + 4 * F.lane + 256 * j);
    for (int m = gw; m < M; m += NGW) {
        const GAS f32x4* xr = (const GAS f32x4*)(F.x + (size_t)m * D) + F.lane;
        f32x4 v[4]; float s = 0.f;
#pragma unroll
        for (int j = 0; j < 4; ++j) { v[j] = xr[64 * j]; s += (v[j].x * v[j].x + v[j].y * v[j].y) + (v[j].z * v[j].z + v[j].w * v[j].w); }
        const float rstd = __builtin_amdgcn_rsqf(wave_sum(s) * (1.f / D) + NORM_EPS);
        GAS unsigned long long* o8 = (GAS unsigned long long*)(F.XN + (size_t)m * D) + F.lane;
#pragma unroll
        for (int j = 0; j < 4; ++j) { const f32x4 o = v[j] * gq[j] * rstd; o8[64 * j] = (unsigned long long)pk2(o.x, o.y) | ((unsigned long long)pk2(o.z, o.w) << 32); }
    }
}

__device__ __forceinline__ int t5_bucket_dev(int dist) {
    if (dist < 16) return dist;
    int l = 16 + (int)(__builtin_log2f((float)dist * (1.0f / 16.0f)) * (16.0f / 7.0f));
    return l < 31 ? l : 31;
}
__device__ __forceinline__ void p2_naive(Frame& F) {
    const int gw = F.vcu * NWAVES + F.wave, NGW = F.G * NWAVES, lane = F.lane;
    for (int idx = gw; idx < M * NH; idx += NGW) {
        const int row = idx >> 3, h = idx & 7, b = row >> 13, t = row & 8191;
        const size_t hb = (size_t)(b * 8 + h) * 8192;
        const GAS v4u* qp = (const GAS v4u*)(F.Q + (hb + t) * 64);
        float q[64];
#pragma unroll
        for (int c = 0; c < 8; ++c) { const v4u w = qp[c]; q[8 * c] = bflo(w.x); q[8 * c + 1] = bfhi(w.x); q[8 * c + 2] = bflo(w.y); q[8 * c + 3] = bfhi(w.y); q[8 * c + 4] = bflo(w.z); q[8 * c + 5] = bfhi(w.z); q[8 * c + 6] = bflo(w.w); q[8 * c + 7] = bfhi(w.w); }
        float s[7]; float mx = -INFINITY;
#pragma unroll
        for (int rd = 0; rd < 7; ++rd) {
            const int e = rd * 64 + lane, p = e / 129, i = e - p * 129, d = p == 0 ? 1 : (p == 1 ? 4 : 16);
            const int tk = t - i * d; const bool valid = (e < 387) && (tk >= 0);
            const GAS v4u* kp = (const GAS v4u*)(F.K + (hb + (valid ? tk : 0)) * 64);
            float dot = 0.f;
#pragma unroll
            for (int c = 0; c < 8; ++c) { const v4u w = kp[c];
                dot += q[8 * c] * bflo(w.x) + q[8 * c + 1] * bfhi(w.x) + q[8 * c + 2] * bflo(w.y) + q[8 * c + 3] * bfhi(w.y) + q[8 * c + 4] * bflo(w.z) + q[8 * c + 5] * bfhi(w.z) + q[8 * c + 6] * bflo(w.w) + q[8 * c + 7] * bfhi(w.w); }
            const float bias = F.rel_bias[t5_bucket_dev(valid ? i * d : 0) * NH + h] * LOG2E;
            s[rd] = valid ? dot + bias : -INFINITY;
            mx = __builtin_fmaxf(mx, s[rd]);
        }
        mx = wave_max(mx);
        float l = 0.f;
#pragma unroll
        for (int rd = 0; rd < 7; ++rd) { s[rd] = __builtin_amdgcn_exp2f(s[rd] - mx); l += s[rd]; }
        l = wave_sum(l);
        float o = 0.f;
#pragma unroll
        for (int rd = 0; rd < 7; ++rd) {
            for (int j = 0; j < 64; ++j) {
                const int e = rd * 64 + j; if (e >= 387) break;
                const int p = e / 129, i = e - p * 129, d = p == 0 ? 1 : (p == 1 ? 4 : 16), tk = t - i * d;
                const float pe = __shfl(s[rd], j);
                if (tk >= 0) o += pe * bf2f(F.V[(hb + tk) * 64 + lane]);
            }
        }
        F.MIX[(size_t)row * D + PW + h * 64 + lane] = (bf16)f2bf(o / l);
    }
    const size_t gt = (size_t)(F.vcu * NWAVES + F.wave) * 64 + lane, NT = (size_t)F.G * NWAVES * 64;
    for (size_t idx = gt; idx < (size_t)M * PW; idx += NT) {
        const int row = (int)(idx >> 9), c = (int)(idx & 511), g = c >> 7, w = 2 << g, t = row & 8191, cnt = (t + 1 < w) ? t + 1 : w;
        float sum = 0.f;
        for (int i = 0; i < cnt; ++i) sum += bf2f(F.U[(size_t)(row - i) * PW + c]);
        const float u0 = bf2f(F.U[(size_t)row * PW + c]);
        F.MIX[(size_t)row * D + c] = (bf16)f2bf(sum / (float)cnt - u0);
    }
}

struct Args { const float* in[12]; float* out; unsigned char* ws; int ph_lo, ph_hi, li, pad; };
__global__ void __launch_bounds__(NWAVES * 64, 2) mk_fwd(Args args) {
    extern __shared__ __attribute__((aligned(16))) unsigned char lds[];
    Frame F;
    F.lds = (LAS unsigned char*)lds;
    F.MISC = (volatile LAS unsigned*)(F.lds + MISC_OFF);
    F.tid = threadIdx.x; F.lane = F.tid & 63; F.wave = __builtin_amdgcn_readfirstlane(F.tid >> 6);
    F.G = gridDim.x; { const int bx = blockIdx.x; F.vcu = (F.G % 8 == 0) ? (bx % 8) * (F.G / 8) + bx / 8 : bx; }
    unsigned char* ws = args.ws;
    F.ctl = (gu32*)(ws + WS_CTL);
    F.x = args.in[0]; F.g1 = args.in[1]; F.w_in = args.in[2]; F.pool_w = args.in[3]; F.pool_s = args.in[4]; F.qg = args.in[5]; F.kg = args.in[6]; F.rel_bias = args.in[7];
    F.w_out = args.in[8]; F.g2 = args.in[9]; F.w_up = args.in[10]; F.w_dn = args.in[11]; F.out = args.out;
    F.Win_t = (bf16*)(ws + WS_WIN); F.Wout_t = (bf16*)(ws + WS_WOUT); F.Wup_t = (bf16*)(ws + WS_WUP); F.Wdn_t = (bf16*)(ws + WS_WDN);
    F.XN = (bf16*)(ws + WS_XN); F.U = (bf16*)(ws + WS_U); F.Q = (bf16*)(ws + WS_Q); F.K = (bf16*)(ws + WS_K); F.V = (bf16*)(ws + WS_V); F.PO = (bf16*)(ws + WS_PO);
    F.MIX = (bf16*)(ws + WS_MIX); F.HB = (bf16*)(ws + WS_HB); F.FFB = (bf16*)(ws + WS_FF); F.RSS = (float*)(ws + WS_RSS); F.PL = (float*)(ws + WS_PL);
    for (int u = F.tid; u < (LDS_BYTES - LDSCTL_OFF) / 4; u += NWAVES * 64) ((LAS unsigned*)(F.lds + LDSCTL_OFF))[u] = 0u;
    __syncthreads();
    XcdBarrier bar; bar.bar = (unsigned*)(F.ctl + CW_BAR); bar.x = 0; bar.st = nullptr;
    if (!MK_PER_PHASE) bar = xcd_barrier_post((unsigned*)(F.ctl + CW_BAR), F.MISC + 8);
    const int lo = args.ph_lo, hi = args.ph_hi;
#define IN(k) (lo <= (k) && (k) < hi)
#define BOTH(k) (IN(k) && IN((k) + 1))
#define GRID_BAR() do { if (!MK_PER_PHASE) xcd_barrier(bar); } while (0)

    if (IN(0)) { p0_prologue(F); if (BOTH(0)) GRID_BAR(); }

    if (IN(1)) {
        pg8::Gemm g{F.XN, F.Win_t, M, NIN, D}; pg8::StaticOrder S; S.init(M, NIN, F.G, (int)blockIdx.x);
        pg8::EpiInProj E{F.U, F.Q, F.K, F.V, F.qg, F.kg};
        pg8::gemm_phase<pg8::EpiInProj, pg8::StaticOrder, true, true>(F.lds + RING_OFF, g, S, E);
        if (BOTH(1)) GRID_BAR();
    }
    if (IN(2)) { p2_naive(F); if (BOTH(2)) GRID_BAR(); }

    if (IN(3)) {
        pg8::Gemm g{F.MIX, F.Wout_t, M, D, D}; pg8::StaticOrder S; S.init(M, D, F.G, (int)blockIdx.x);
        pg8::EpiOut E{F.x, F.out, F.HB, F.RSS};
        pg8::gemm_phase<pg8::EpiOut, pg8::StaticOrder, true, true>(F.lds + RING_OFF, g, S, E);
        if (BOTH(3)) GRID_BAR();
    }
    if (IN(4)) {
        pg8::Gemm g{F.HB, F.Wup_t, M, FF, D}; pg8::StaticOrder S; S.init(M, FF, F.G, (int)blockIdx.x);
        pg8::EpiUp E{F.RSS, F.FFB};
        pg8::gemm_phase<pg8::EpiUp, pg8::StaticOrder, true, true>(F.lds + RING_OFF, g, S, E);
        if (BOTH(4)) GRID_BAR();
    }
    if (IN(5)) {
        pg8::Gemm g{F.FFB, F.Wdn_t, M, D, FF}; pg8::StaticOrder S; S.init(M, D, F.G, (int)blockIdx.x);
        pg8::EpiDown E{F.out};
        pg8::gemm_phase<pg8::EpiDown, pg8::StaticOrder, true, true>(F.lds + RING_OFF, g, S, E);
    }
#undef IN
#undef BOTH
#undef GRID_BAR
}

extern "C" void kernel_launch(void* const* d_in, const int* in_sizes, int n_in, void* d_out, int out_size, void* d_ws, size_t ws_size, hipStream_t stream) {
    static int grid = 0;
    if (grid == 0) {
        if (n_in != 12 || in_sizes[0] != M * D || out_size != M * D || ws_size < WS_END) { fprintf(stderr, "kernel_launch: unexpected shapes (n_in %d, in0 %d, out %d, ws %zu); nothing launched\n", n_in, n_in > 0 ? in_sizes[0] : -1, out_size, ws_size); grid = -1; return; }
        int dev = 0, cus = 0;
        if (hipGetDevice(&dev) != hipSuccess || hipDeviceGetAttribute(&cus, hipDeviceAttributeMultiprocessorCount, dev) != hipSuccess) { grid = -1; return; }
        if (hipFuncSetAttribute((const void*)mk_fwd, hipFuncAttributeMaxDynamicSharedMemorySize, LDS_BYTES) != hipSuccess) { fprintf(stderr, "kernel_launch: hipFuncSetAttribute failed\n"); grid = -1; return; }
        int per_cu = 0;
        if (hipOccupancyMaxActiveBlocksPerMultiprocessor(&per_cu, (const void*)mk_fwd, NWAVES * 64, LDS_BYTES) != hipSuccess || per_cu < 1) fprintf(stderr, "kernel_launch: occupancy query says %d\n", per_cu);
        (void)hipGetLastError();
        grid = cus;
    }
    if (grid < 0) return;
    if (hipMemsetAsync((char*)d_ws + WS_CTL, 0, CTL_ZERO_BYTES, stream) != hipSuccess) return;
    Args a{};
    for (int i = 0; i < 12; ++i) a.in[i] = (const float*)d_in[i];
    a.out = (float*)d_out; a.ws = (unsigned char*)d_ws;
#if MK_PER_PHASE
    for (int li = 0; li < NPHASE; ++li) { a.ph_lo = li; a.ph_hi = li + 1; a.li = li; hipLaunchKernelGGL(mk_fwd, dim3(grid), dim3(NWAVES * 64), LDS_BYTES, stream, a); }
#else
    a.ph_lo = 0; a.ph_hi = NPHASE; a.li = 0;
    hipLaunchKernelGGL(mk_fwd, dim3(grid), dim3(NWAVES * 64), LDS_BYTES, stream, a);
#endif
}
```

```cpp
#include <hip/hip_runtime.h>
#include <cstdio>
#include <cstdint>
namespace pg8 {
#define PG8_LAS __attribute__((address_space(3)))
typedef unsigned short bf16_t;
typedef short bf16x8 __attribute__((ext_vector_type(8)));
typedef float f32x4 __attribute__((ext_vector_type(4)));
typedef unsigned u32x4 __attribute__((ext_vector_type(4)));
constexpr int BM = 256, BK = 64, HALF = 128, HTB = HALF * BK * 2  , STAGE_BYTES = 8 * HTB, NXCD = 8, WGM = 8;

__host__ __device__ __forceinline__ int lds_byte(int r, int c) { const int st = (r >> 4) * 2 + (c >> 5), rr = r & 15, cc = c & 31, ob = rr * 64 + cc * 2; return st * 1024 + (ob ^ (((ob >> 9) & 1) << 5)); }
__host__ __device__ __forceinline__ void stage_rc(int b, int& R, int& C) { const int st = b / 1024, sb = b % 1024, swz = sb ^ (((sb >> 9) & 1) << 5); R = (st >> 1) * 16 + swz / 64; C = (st & 1) * 32 + (swz % 64) / 2; }
__host__ __device__ __forceinline__ unsigned stage_lin(int b) { const int st = b / 1024, sb = b % 1024; return (unsigned)(st * 1024 + (sb ^ (((sb >> 9) & 1) << 5))); }
__host__ __device__ __forceinline__ int perm32(int rho) { const int n = rho >> 4, i = rho & 15; return 8 * (i >> 2) + 4 * n + (i & 3); }

struct Unit { int pm, pn; };
struct Gemm { const bf16_t* A; const bf16_t* Bt; int M, N, K; };

struct StaticOrder {
    int nM, nN, nwg, G, c;
    __host__ __device__ void init(int M, int N, int G_, int c_) { nM = M / BM; nN = N / BM; nwg = nM * nN; G = G_; c = c_; }
    __host__ __device__ bool next(int i, Unit& u) const {
        const long L = (long)i * G + c; if (L >= nwg) return false;
        int wgid = (int)L; { const int q = nwg / NXCD, r = nwg % NXCD, xcd = wgid % NXCD, off = wgid / NXCD; wgid = (xcd < r ? xcd * (q + 1) : r * (q + 1) + (xcd - r) * q) + off; }
        const int nig = WGM * nN, gid = wgid / nig, fm = gid * WGM, gsz = (nM - fm) < WGM ? (nM - fm) : WGM;
        u.pm = fm + ((wgid % nig) % gsz); u.pn = (wgid % nig) / gsz; return true;
    }
    __device__ __forceinline__ void a_ready(const Unit&) const {}
    __device__ __forceinline__ void done(const Unit&) const {}
};

__device__ __forceinline__ unsigned cvt_pk_bf16(float lo, float hi) { unsigned r; asm volatile("v_cvt_pk_bf16_f32 %0, %1, %2" : "=v"(r) : "v"(lo), "v"(hi)); return r; }
typedef float f32x2 __attribute__((ext_vector_type(2)));
template <class Epi, class Sched, bool ALIGN_EPI = false, bool SP2 = false, bool ATILED = false, int AUXA = 0, int AUXB = 0>
__device__ __forceinline__ void gemm_phase(PG8_LAS unsigned char* lds, const Gemm g, const Sched& S, const Epi& E) {
    const int tid = threadIdx.x, wid = __builtin_amdgcn_readfirstlane(tid >> 6), lane = tid & 63, wr = wid >> 2, wc = wid & 3, fr = lane & 15, fq = lane >> 4;
    const int K = g.K, nt = K / BK;
    unsigned voffA[2], voffB[2];
#pragma unroll
    for (int i = 0; i < 2; ++i) { int R, C; stage_rc(tid * 16 + i * 8192, R, C); const int Rb = Epi::PERM ? ((R & ~31) + perm32(R & 31)) : R;
        voffA[i] = ATILED ? stage_lin(tid * 16 + i * 8192) : (unsigned)(R * K + C) * 2u; voffB[i] = ATILED ? stage_lin(tid * 16 + i * 8192) : (unsigned)(Rb * K + C) * 2u; }
    const size_t kstep = ATILED ? (size_t)32768 : (size_t)(BK * 2);
    const size_t hstep = ATILED ? (size_t)16384 : (size_t)HALF * K * 2;
    const size_t kstepA = ATILED ? (size_t)32768 : kstep, hstepA = ATILED ? (size_t)16384 : hstep;
    const size_t tstep = (size_t)2 * HALF * K * 2;
    const unsigned ldsw = (unsigned)wid * 1024u;
    const int aoff = lds_byte(wr * 64 + fr, fq * 8), boff = lds_byte(wc * 32 + fr, fq * 8);
#define PG8_SA(b, h) (((b) * 2 + (h)) * HTB)
#define PG8_SB(b, h) ((4 + (b) * 2 + (h)) * HTB)
#ifndef PG8_DMA_AUX_A
#define PG8_DMA_AUX_A 0
#endif
#ifndef PG8_DMA_AUX_B
#define PG8_DMA_AUX_B 0
#endif
#define PG8_STAGE_X(bufoff, gbase, voff, AUX) do { _Pragma("unroll") for (int _i = 0; _i < 2; ++_i) \
        __builtin_amdgcn_global_load_lds((const unsigned*)((const char*)(gbase) + (voff)[_i]), (PG8_LAS unsigned*)(lds + (bufoff) + ldsw + _i * 8192), 16, 0, AUX); } while (0)
#define PG8_LDA(dst, b, h) do { _Pragma("unroll") for (int m = 0; m < 4; ++m) _Pragma("unroll") for (int k = 0; k < 2; ++k) dst[m][k] = *(const PG8_LAS bf16x8*)(lds + PG8_SA(b, h) + aoff + m * 2048 + k * 1024); } while (0)
#define PG8_LDB(dst, b, h) do { _Pragma("unroll") for (int n = 0; n < 2; ++n) _Pragma("unroll") for (int k = 0; k < 2; ++k) dst[n][k] = *(const PG8_LAS bf16x8*)(lds + PG8_SB(b, h) + boff + n * 2048 + k * 1024); } while (0)
#define PG8_MMA(ai, bj, At, Bt) do { __builtin_amdgcn_s_setprio(1); _Pragma("unroll") for (int m = 0; m < 4; ++m) _Pragma("unroll") for (int n = 0; n < 2; ++n) _Pragma("unroll") for (int k = 0; k < 2; ++k) \
        acc[ai][bj][m][n] = __builtin_amdgcn_mfma_f32_16x16x32_bf16(Bt[n][k], At[m][k], acc[ai][bj][m][n], 0, 0, 0); __builtin_amdgcn_s_setprio(0); } while (0)
#define PG8_WAIT_V(n) asm volatile("s_waitcnt vmcnt(" #n ")" ::: "memory")
#define PG8_WAIT_L(n) asm volatile("s_waitcnt lgkmcnt(" #n ")" ::: "memory")
#define PG8_BAR __builtin_amdgcn_s_barrier()
#define PG8_SCHED __builtin_amdgcn_sched_barrier(0)
    Unit cur, nxt; int ui = 0;
    if (!S.next(0, cur)) return;
    f32x4 acc[2][2][4][2];
#pragma unroll
    for (int a = 0; a < 2; ++a)
#pragma unroll
        for (int b = 0; b < 2; ++b)
#pragma unroll
            for (int m = 0; m < 4; ++m)
#pragma unroll
                for (int n = 0; n < 2; ++n) acc[a][b][m][n] = (f32x4){0.f, 0.f, 0.f, 0.f};
    bf16x8 At[4][2], B0[2][2], B1[2][2];
    const char* cA = (const char*)g.A + (size_t)cur.pm * tstep; const char* cB = (const char*)g.Bt + (size_t)cur.pn * tstep;
    S.a_ready(cur);
    if constexpr (SP2) {
        PG8_STAGE_X(PG8_SB(0, 0), cB, voffB, AUXB); PG8_STAGE_X(PG8_SB(0, 1), cB + hstep, voffB, AUXB); PG8_STAGE_X(PG8_SA(0, 0), cA, voffA, AUXA); PG8_STAGE_X(PG8_SA(0, 1), cA + hstepA, voffA, AUXA);
        if (wr == 1) PG8_BAR;
        PG8_WAIT_V(2); PG8_BAR;
        PG8_STAGE_X(PG8_SB(1, 0), cB + kstep, voffB, AUXB); PG8_STAGE_X(PG8_SA(1, 0), cA + kstepA, voffA, AUXA); PG8_STAGE_X(PG8_SB(1, 1), cB + hstep + kstep, voffB, AUXB);
        PG8_WAIT_V(6); PG8_BAR;
    } else {
        PG8_STAGE_X(PG8_SB(0, 0), cB, voffB, AUXB); PG8_STAGE_X(PG8_SA(0, 0), cA, voffA, AUXA); PG8_STAGE_X(PG8_SB(0, 1), cB + hstep, voffB, AUXB); PG8_STAGE_X(PG8_SA(0, 1), cA + hstepA, voffA, AUXA);
        if (wr == 1) PG8_BAR;
        PG8_WAIT_V(4); PG8_BAR;
        PG8_STAGE_X(PG8_SB(1, 0), cB + kstep, voffB, AUXB); PG8_STAGE_X(PG8_SA(1, 0), cA + kstepA, voffA, AUXA); PG8_STAGE_X(PG8_SB(1, 1), cB + hstep + kstep, voffB, AUXB);
        PG8_WAIT_V(6); PG8_BAR;
    }
    for (;;) {
        const bool has_next = S.next(ui + 1, nxt);
        const char* nA = has_next ? (const char*)g.A + (size_t)nxt.pm * tstep : cA; const char* nB = has_next ? (const char*)g.Bt + (size_t)nxt.pn * tstep : cB;
        for (int t = 0; t < nt; t += 2) {
            const bool last = (t == nt - 2);
            const char* a1 = cA + (size_t)(t + 1) * kstepA;
            const char* a2 = last ? nA : cA + (size_t)(t + 2) * kstepA; const char* b2 = last ? nB : cB + (size_t)(t + 2) * kstep;
            const char* a3 = a2 + kstepA; const char* b3 = b2 + kstep;
            if (last && has_next) S.a_ready(nxt);
            if constexpr (SP2) {
            PG8_LDB(B0, 0, 0); PG8_LDB(B1, 0, 1); PG8_SCHED; PG8_LDA(At, 0, 0); PG8_STAGE_X(PG8_SA(1, 1), a1 + hstepA, voffA, AUXA);
            PG8_WAIT_V(8); PG8_WAIT_L(0); PG8_BAR; PG8_MMA(0, 0, At, B0); PG8_MMA(0, 1, At, B1); PG8_BAR; PG8_SCHED;
            PG8_LDA(At, 0, 1); PG8_STAGE_X(PG8_SB(0, 0), b2, voffB, AUXB); PG8_STAGE_X(PG8_SB(0, 1), b2 + hstep, voffB, AUXB); PG8_STAGE_X(PG8_SA(0, 0), a2, voffA, AUXA);
            PG8_WAIT_V(8); PG8_WAIT_L(0); PG8_BAR; PG8_MMA(1, 0, At, B0); PG8_MMA(1, 1, At, B1); PG8_BAR; PG8_SCHED;
            PG8_LDB(B0, 1, 0); PG8_LDB(B1, 1, 1); PG8_SCHED; PG8_LDA(At, 1, 0); PG8_STAGE_X(PG8_SA(0, 1), a2 + hstepA, voffA, AUXA);
            PG8_WAIT_V(8); PG8_WAIT_L(0); PG8_BAR; PG8_MMA(0, 0, At, B0); PG8_MMA(0, 1, At, B1); PG8_BAR; PG8_SCHED;
            PG8_LDA(At, 1, 1); PG8_STAGE_X(PG8_SB(1, 0), b3, voffB, AUXB); PG8_STAGE_X(PG8_SB(1, 1), b3 + hstep, voffB, AUXB); PG8_STAGE_X(PG8_SA(1, 0), a3, voffA, AUXA);
            PG8_WAIT_V(8); PG8_WAIT_L(0); PG8_BAR; PG8_MMA(1, 0, At, B0); PG8_MMA(1, 1, At, B1); PG8_BAR; PG8_SCHED;
            } else {
            PG8_LDB(B0, 0, 0); PG8_SCHED; PG8_LDA(At, 0, 0); PG8_STAGE_X(PG8_SA(1, 1), a1 + hstepA, voffA, AUXA);
            PG8_WAIT_L(8); PG8_BAR; PG8_WAIT_L(0); PG8_MMA(0, 0, At, B0); PG8_BAR; PG8_SCHED;
            PG8_LDB(B1, 0, 1); PG8_STAGE_X(PG8_SB(0, 0), b2, voffB, AUXB);
            PG8_BAR; PG8_WAIT_L(0); PG8_MMA(0, 1, At, B1); PG8_BAR;
            PG8_LDA(At, 0, 1); PG8_STAGE_X(PG8_SA(0, 0), a2, voffA, AUXA);
            PG8_BAR; PG8_WAIT_L(0); PG8_MMA(1, 0, At, B0); PG8_BAR; PG8_SCHED;
            PG8_STAGE_X(PG8_SB(0, 1), b2 + hstep, voffB, AUXB);
            PG8_WAIT_V(6); PG8_BAR; PG8_MMA(1, 1, At, B1); PG8_BAR;
            PG8_LDB(B0, 1, 0); PG8_SCHED; PG8_LDA(At, 1, 0); PG8_STAGE_X(PG8_SA(0, 1), a2 + hstepA, voffA, AUXA);
            PG8_WAIT_L(8); PG8_BAR; PG8_WAIT_L(0); PG8_MMA(0, 0, At, B0); PG8_BAR; PG8_SCHED;
            PG8_LDB(B1, 1, 1); PG8_STAGE_X(PG8_SB(1, 0), b3, voffB, AUXB);
            PG8_BAR; PG8_WAIT_L(0); PG8_MMA(0, 1, At, B1); PG8_BAR;
            PG8_LDA(At, 1, 1); PG8_STAGE_X(PG8_SA(1, 0), a3, voffA, AUXA);
            PG8_BAR; PG8_WAIT_L(0); PG8_MMA(1, 0, At, B0); PG8_BAR; PG8_SCHED;
            PG8_STAGE_X(PG8_SB(1, 1), b3 + hstep, voffB, AUXB);
            PG8_WAIT_V(6); PG8_BAR; PG8_MMA(1, 1, At, B1); PG8_BAR;
            }
        }
        if constexpr (ALIGN_EPI) { if (wr == 0) PG8_BAR; }
        if constexpr (!Epi::AFTER_DRAIN) { E(acc, cur, wr, wc, fr, fq); S.done(cur); }
        if (!has_next) break;
#pragma unroll
        for (int a = 0; a < 2; ++a)
#pragma unroll
            for (int b = 0; b < 2; ++b)
#pragma unroll
                for (int m = 0; m < 4; ++m)
#pragma unroll
                    for (int n = 0; n < 2; ++n) acc[a][b][m][n] = (f32x4){0.f, 0.f, 0.f, 0.f};
        cur = nxt; cA = nA; cB = nB; ++ui;
        if constexpr (ALIGN_EPI) { if (wr == 1) PG8_BAR; }
    }
    PG8_WAIT_V(0);
    if constexpr (!ALIGN_EPI) { if (wr == 0) PG8_BAR; }
    PG8_BAR;
    if constexpr (Epi::AFTER_DRAIN) { E.fused(acc, cur, wr, wc, fr, fq, lds, wid, lane); S.done(cur); }
#undef PG8_SA
#undef PG8_SB
#undef PG8_STAGE_X
#undef PG8_LDA
#undef PG8_LDB
#undef PG8_MMA
#undef PG8_WAIT_V
#undef PG8_WAIT_L
#undef PG8_BAR
#undef PG8_SCHED
}
}
namespace pg8 {
constexpr float NORM_EPS_F = 1e-6f;
constexpr float C2 = 0.125f * 1.4426950408889634f;
__device__ __forceinline__ size_t tiled_off(int row, int col, int KT) { return ((((size_t)(row >> 8) * KT + (col >> 6)) * 32 + ((row & 255) >> 4) * 2 + ((col & 63) >> 5)) * 512) + (row & 15) * 32 + (col & 31); }
__host__ __device__ __forceinline__ int perm32inv(int x) { return 16 * ((x >> 2) & 1) + 4 * (x >> 3) + (x & 3); }
__device__ __forceinline__ float row4_sum(float s) {
    unsigned a = __builtin_bit_cast(unsigned, s), b = a; asm volatile("" : "+v"(b));
    auto r = __builtin_amdgcn_permlane16_swap(a, b, false, false);
    unsigned r0 = r[0], r1 = r[1]; asm volatile("" : "+v"(r0), "+v"(r1));
    s = __builtin_bit_cast(float, r0) + __builtin_bit_cast(float, r1);
    a = __builtin_bit_cast(unsigned, s); b = a; asm volatile("" : "+v"(b));
    auto q = __builtin_amdgcn_permlane32_swap(a, b, false, false);
    unsigned q0 = q[0], q1 = q[1]; asm volatile("" : "+v"(q0), "+v"(q1));
    return __builtin_bit_cast(float, q0) + __builtin_bit_cast(float, q1);
}
__device__ __forceinline__ float hsum4(const f32x4 v) { return (v[0] + v[1]) + (v[2] + v[3]); }
__device__ __forceinline__ float hsq4(const f32x4 v) { return (v[0] * v[0] + v[1] * v[1]) + (v[2] * v[2] + v[3] * v[3]); }
__device__ __forceinline__ u32x4 pack8(const f32x4 a, const f32x4 b) { u32x4 w; w.x = cvt_pk_bf16(a[0], a[1]); w.y = cvt_pk_bf16(a[2], a[3]); w.z = cvt_pk_bf16(b[0], b[1]); w.w = cvt_pk_bf16(b[2], b[3]); return w; }

struct EpiInProj {
    static constexpr bool PERM = true, AFTER_DRAIN = false;
    bf16_t *U, *Q, *K, *V; const float *qg, *kg;
    __device__ __forceinline__ void operator()(const f32x4 (&acc)[2][2][4][2], const Unit& u, int wr, int wc, int fr, int fq) const {
        const int row0 = u.pm * BM + wr * 64 + fr;
        const int kind = u.pn >> 1;
        if (kind == 0) {
            const int col0 = (u.pn & 1) * 256 + 64 * wc + 8 * fq;
#pragma unroll
            for (int ai = 0; ai < 2; ++ai)
#pragma unroll
                for (int m = 0; m < 4; ++m) { bf16_t* rowp = U + (size_t)(row0 + ai * HALF + m * 16) * 512 + col0;
#pragma unroll
                    for (int bj = 0; bj < 2; ++bj) *(u32x4*)(rowp + 32 * bj) = pack8(acc[ai][bj][m][0], acc[ai][bj][m][1]); }
        } else {
            const int head = 4 * (u.pn & 1) + wc;
            bf16_t* dst = kind == 1 ? Q : (kind == 2 ? K : V);
            const float* g = kind == 1 ? qg : kg;
            const float gs = kind == 1 ? C2 : 1.0f;
            f32x4 gv[2][2];
#pragma unroll
            for (int bj = 0; bj < 2; ++bj)
#pragma unroll
                for (int n = 0; n < 2; ++n) gv[bj][n] = (kind == 3) ? (f32x4){1.f, 1.f, 1.f, 1.f} : *(const f32x4*)(g + 32 * bj + 8 * fq + 4 * n) * gs;
#pragma unroll
            for (int ai = 0; ai < 2; ++ai)
#pragma unroll
                for (int m = 0; m < 4; ++m) {
                    const int row = row0 + ai * HALF + m * 16, b = row >> 13, t = row & 8191;
                    bf16_t* rowp = dst + ((size_t)(b * 8 + head) * 8192 + t) * 64 + 8 * fq;
                    float ss = (hsq4(acc[ai][0][m][0]) + hsq4(acc[ai][0][m][1])) + (hsq4(acc[ai][1][m][0]) + hsq4(acc[ai][1][m][1]));
                    ss = row4_sum(ss);
                    const float r = (kind == 3) ? 1.0f : __builtin_amdgcn_rsqf(ss * (1.0f / 64.0f) + NORM_EPS_F);
#pragma unroll
                    for (int bj = 0; bj < 2; ++bj) *(u32x4*)(rowp + 32 * bj) = pack8(acc[ai][bj][m][0] * gv[bj][0] * r, acc[ai][bj][m][1] * gv[bj][1] * r);
                }
        }
    }
};
struct EpiOut {
    static constexpr bool PERM = true, AFTER_DRAIN = false;
    const bf16_t* XN; const float* RN1; bf16_t* HB; float* RSS;
    __device__ __forceinline__ void operator()(const f32x4 (&acc)[2][2][4][2], const Unit& u, int wr, int wc, int fr, int fq) const {
        const int row0 = u.pm * BM + wr * 64 + fr, col0 = u.pn * BM + wc * 32 + 8 * fq;
#pragma unroll
        for (int ai = 0; ai < 2; ++ai) {
            u32x4 xv[4][2]; float rn[4];
#pragma unroll
            for (int m = 0; m < 4; ++m) { const int row = row0 + ai * HALF + m * 16; rn[m] = RN1[row];
#pragma unroll
                for (int bj = 0; bj < 2; ++bj) xv[m][bj] = __builtin_nontemporal_load((const u32x4*)(XN + tiled_off(row, col0 + bj * HALF, 16))); }
#pragma unroll
            for (int m = 0; m < 4; ++m) {
                const int row = row0 + ai * HALF + m * 16; float ss = 0.f; const float rnv = rn[m];
#pragma unroll
                for (int bj = 0; bj < 2; ++bj) {
                    const u32x4 v = xv[m][bj];
                    f32x4 x0, x1;
                    x0[0] = __builtin_bit_cast(float, v.x << 16); x0[1] = __builtin_bit_cast(float, v.x & 0xffff0000u); x0[2] = __builtin_bit_cast(float, v.y << 16); x0[3] = __builtin_bit_cast(float, v.y & 0xffff0000u);
                    x1[0] = __builtin_bit_cast(float, v.z << 16); x1[1] = __builtin_bit_cast(float, v.z & 0xffff0000u); x1[2] = __builtin_bit_cast(float, v.w << 16); x1[3] = __builtin_bit_cast(float, v.w & 0xffff0000u);
                    const f32x4 h0 = x0 * rnv + acc[ai][bj][m][0], h1 = x1 * rnv + acc[ai][bj][m][1];
                    ss += hsq4(h0) + hsq4(h1);
                    *(u32x4*)(HB + tiled_off(row, col0 + bj * HALF, 16)) = pack8(h0, h1);
                }
                ss = row4_sum(ss);
                if (fq == 0) RSS[(size_t)row * 16 + u.pn * 4 + wc] = ss;
            }
        }
    }
};
struct EpiUp {
    static constexpr bool PERM = true, AFTER_DRAIN = false;
    bf16_t* FF;
    __device__ __forceinline__ void operator()(const f32x4 (&acc)[2][2][4][2], const Unit& u, int wr, int wc, int fr, int fq) const {
        const int row0 = u.pm * BM + wr * 64 + fr, col0 = u.pn * BM + wc * 32 + 8 * fq;
#pragma unroll
        for (int ai = 0; ai < 2; ++ai)
#pragma unroll
            for (int m = 0; m < 4; ++m) {
                const int row = row0 + ai * HALF + m * 16;
#pragma unroll
                for (int bj = 0; bj < 2; ++bj) {
                    f32x4 v0 = acc[ai][bj][m][0], v1 = acc[ai][bj][m][1];
#pragma unroll
                    for (int e = 0; e < 4; ++e) { v0[e] = __builtin_fmaxf(v0[e], 0.f); v1[e] = __builtin_fmaxf(v1[e], 0.f); }
                    __builtin_nontemporal_store(pack8(v0 * v0, v1 * v1), (u32x4*)(FF + tiled_off(row, col0 + bj * HALF, 64)));
                }
            }
    }
};
struct EpiDown {
    static constexpr bool PERM = false, AFTER_DRAIN = false;
    const bf16_t* HB; const float* RSS; float* out;
    __device__ __forceinline__ void operator()(const f32x4 (&acc)[2][2][4][2], const Unit& u, int wr, int wc, int fr, int fq) const {
        typedef unsigned u32x2 __attribute__((ext_vector_type(2)));
        const int row0 = u.pm * BM + wr * 64 + fr, col0 = u.pn * BM + wc * 32 + 4 * fq;
#pragma unroll
        for (int ai = 0; ai < 2; ++ai) {
            u32x2 hv[4][2][2]; f32x4 rsv[4];
#pragma unroll
            for (int m = 0; m < 4; ++m) { rsv[m] = *(const f32x4*)(RSS + (size_t)(row0 + ai * HALF + m * 16) * 16 + 4 * fq);
#pragma unroll
                for (int bj = 0; bj < 2; ++bj)
#pragma unroll
                    for (int n = 0; n < 2; ++n) hv[m][bj][n] = __builtin_nontemporal_load((const u32x2*)(HB + tiled_off(row0 + ai * HALF + m * 16, col0 + bj * HALF + 16 * n, 16))); }
#pragma unroll
            for (int m = 0; m < 4; ++m) { const int row = row0 + ai * HALF + m * 16; const size_t off = (size_t)row * 1024 + col0;
                const float s2 = 1.0f / (row4_sum(hsum4(rsv[m])) * (1.0f / 1024.0f) + NORM_EPS_F);
#pragma unroll
                for (int bj = 0; bj < 2; ++bj)
#pragma unroll
                    for (int n = 0; n < 2; ++n) { const u32x2 v = hv[m][bj][n];
                        f32x4 h;
                        h[0] = __builtin_bit_cast(float, v.x << 16); h[1] = __builtin_bit_cast(float, v.x & 0xffff0000u); h[2] = __builtin_bit_cast(float, v.y << 16); h[3] = __builtin_bit_cast(float, v.y & 0xffff0000u);
                        *(f32x4*)(out + off + bj * HALF + 16 * n) = h + acc[ai][bj][m][n] * s2; } }
        }
    }
};
}
#include <cmath>
#define GAS __attribute__((address_space(1)))
#define LAS __attribute__((address_space(3)))
typedef unsigned short bf16;
typedef unsigned v4u __attribute__((ext_vector_type(4)));
typedef float f32x4 __attribute__((ext_vector_type(4)));
typedef short bf16x8 __attribute__((ext_vector_type(8)));
typedef GAS unsigned gu32;
typedef GAS unsigned long long gu64;
#define RLX_AGENT __ATOMIC_RELAXED, __HIP_MEMORY_SCOPE_AGENT
#define LDS_WAIT() asm volatile("s_waitcnt lgkmcnt(0)" ::: "memory")
#define VM_WAIT() asm volatile("s_waitcnt vmcnt(0)" ::: "memory")
__device__ __forceinline__ unsigned long long rt() { return __builtin_amdgcn_s_memrealtime(); }
__device__ __forceinline__ unsigned f2bf(float f) { unsigned u = __builtin_bit_cast(unsigned, f); return (u + 0x7fffu + ((u >> 16) & 1u)) >> 16; }
__device__ __forceinline__ unsigned pk2(float lo, float hi) { return f2bf(lo) | (f2bf(hi) << 16); }

#define XB_TMO      128
#define XB_XCNT(j)  (256  + 64 * (j))
#define XB_XSUB(j)  (1280 + 64 * (j))
#define XB_XGEN(j)  (2304 + 64 * (j))
#define XB_TOP      3328
#define XB_TOPGEN   3392
#define XCD_BAR_WORDS 3456
#define XB_SPIN_CAP (1u << 18)

__device__ __forceinline__ unsigned xb_ld(unsigned* p)              { return __hip_atomic_load(p, __ATOMIC_RELAXED, __HIP_MEMORY_SCOPE_AGENT); }
__device__ __forceinline__ unsigned xb_add(unsigned* p, unsigned v) { return __hip_atomic_fetch_add(p, v, __ATOMIC_RELAXED, __HIP_MEMORY_SCOPE_AGENT); }
__device__ __forceinline__ unsigned xb_xcc_id() { return (unsigned)__builtin_amdgcn_s_getreg((3 << 11) | 20) & 0xFu; }
#define XB_SPIN(cond, bar) do { unsigned _sp = 0; while (cond) { __builtin_amdgcn_s_sleep(1); \
    if ((++_sp & 255u) == 0u) { if (xb_ld(&(bar)[XB_TMO])) break; if (_sp > XB_SPIN_CAP) { atomicAdd(&(bar)[XB_TMO], 1u); break; } } } } while (0)

struct XcdBarrier {
    unsigned* bar; unsigned x;
    volatile LAS unsigned* st;
};

__device__ __forceinline__ XcdBarrier xcd_barrier_post(unsigned* bar, volatile LAS unsigned* st) {
    XcdBarrier b; b.bar = bar; b.x = xb_xcc_id(); b.st = st;
    if (threadIdx.x == 0) (void)xb_add(&bar[XB_XCNT(b.x)], 1u);
    return b;
}
__device__ __forceinline__ void xcd_barrier_complete(unsigned* bar, unsigned x, unsigned& nloc, unsigned& nx) {
    const unsigned G = gridDim.x * gridDim.y * gridDim.z;
    unsigned sum, cnt, mine, sp = 0u;
    for (;;) {
        sum = 0u; cnt = 0u; mine = 0u;
#pragma unroll
        for (unsigned j = 0; j < 16; ++j) { const unsigned c = xb_ld(&bar[XB_XCNT(j)]); sum += c; cnt += (c > 0u) ? 1u : 0u; mine = (j == x) ? c : mine; }
        if (sum == G) break;
        __builtin_amdgcn_s_sleep(1);
        if ((++sp & 255u) == 0u) { if (xb_ld(&bar[XB_TMO])) break; if (sp > XB_SPIN_CAP) { atomicAdd(&bar[XB_TMO], 1u); break; } }
    }
    nloc = mine > 0u ? mine : 1u; nx = cnt > 0u ? cnt : 1u;
}

__device__ __forceinline__ void xcd_barrier(const XcdBarrier& b) {
    asm volatile("s_waitcnt vmcnt(0)" ::: "memory");
    __syncthreads();
    if (threadIdx.x == 0) {
        unsigned* bar = b.bar;
        __builtin_amdgcn_s_waitcnt(0);
        unsigned nloc = b.st[0], nx = b.st[1];
        if (nloc == 0u) { xcd_barrier_complete(bar, b.x, nloc, nx); b.st[0] = nloc; b.st[1] = nx; }
        const unsigned old = xb_add(&bar[XB_XSUB(b.x)], 1u);
        const unsigned gen = old / nloc;
        if (old + 1u == (gen + 1u) * nloc) {
            __builtin_amdgcn_fence(__ATOMIC_RELEASE, "agent");
            asm volatile("s_waitcnt vmcnt(0)" ::: "memory");
            const unsigned og = xb_add(&bar[XB_TOP], 1u);
            const unsigned tg = og / nx;
            if (og + 1u == (tg + 1u) * nx) xb_add(&bar[XB_TOPGEN], 1u);
            else XB_SPIN(xb_ld(&bar[XB_TOPGEN]) == tg, bar);
            __builtin_amdgcn_fence(__ATOMIC_ACQUIRE, "agent");
            xb_add(&bar[XB_XGEN(b.x)], 1u);
            asm volatile("s_waitcnt vmcnt(0)" ::: "memory");
        } else {
            XB_SPIN(xb_ld(&bar[XB_XGEN(b.x)]) == gen, bar);
            __builtin_amdgcn_fence(__ATOMIC_ACQUIRE, "agent");
            asm volatile("s_waitcnt vmcnt(0)" ::: "memory");
        }
    }
    __syncthreads();
}
constexpr int NWAVES = 8;
#ifndef MK_PER_PHASE
#define MK_PER_PHASE 0
#endif
constexpr int NPHASE = 9;

constexpr int BATCH = 4, T = 8192, D = 1024, NH = 8, HD = 64, FF = 4096, PW = 512, AW = 512;
constexpr int M = BATCH * T;
constexpr int NIN = PW + 3 * AW;
constexpr float NORM_EPS = 1e-6f;
constexpr float LOG2E = 1.4426950408889634f;

constexpr size_t MiB = 1u << 20;
constexpr size_t WS_CTL = 0, CTL_ZERO_BYTES = 1 * MiB;
constexpr size_t WS_WIN = 1 * MiB, WS_WOUT = 5 * MiB, WS_WUP = 7 * MiB, WS_WDN = 15 * MiB;
constexpr size_t WS_RSS = 23 * MiB;
constexpr size_t WS_PL = 25 * MiB;
constexpr size_t WS_RN1 = 27 * MiB;
constexpr size_t WS_HB = 28 * MiB;
constexpr size_t WS_FF = 92 * MiB;
constexpr size_t WS_XN = 92 * MiB, WS_U = 156 * MiB, WS_Q = 188 * MiB, WS_K = 220 * MiB, WS_V = 252 * MiB, WS_PO = 284 * MiB;
constexpr size_t WS_MIX = 348 * MiB;
constexpr size_t WS_END = 412 * MiB;
static_assert(WS_PO + 64 * MiB <= WS_FF + 256 * MiB && WS_MIX >= WS_FF + 256 * MiB && WS_HB + 64 * MiB <= WS_FF, "d_ws map");
constexpr int CW_BAR = 4096;

constexpr int RING_OFF = 0, RING_BYTES = 131072;
constexpr int LDSCTL_OFF = RING_BYTES, MISC_OFF = LDSCTL_OFF + 320;
constexpr int LDS_BYTES = 147456;

struct Frame {
    LAS unsigned char* lds;
    volatile LAS unsigned* MISC;
    gu32* ctl;
    int tid, lane, wave, vcu, G;
    const float *x, *g1, *w_in, *pool_w, *pool_s, *qg, *kg, *rel_bias, *w_out, *g2, *w_up, *w_dn;
    float* out;
    bf16 *Win_t, *Wout_t, *Wup_t, *Wdn_t;
    bf16 *XN, *U, *Q, *K, *V, *PO, *MIX, *HB, *FFB;
    float *RSS, *PL, *RN1;
};

__device__ __forceinline__ float wave_sum(float v) {
#pragma unroll
    for (int o = 1; o < 64; o <<= 1) v += __shfl_xor(v, o);
    return v;
}
__device__ __forceinline__ float wave_max(float v) {
#pragma unroll
    for (int o = 1; o < 64; o <<= 1) v = __builtin_fmaxf(v, __shfl_xor(v, o));
    return v;
}
__device__ __forceinline__ float bf2f(unsigned short h) { return __builtin_bit_cast(float, (unsigned)h << 16); }
__device__ __forceinline__ float bflo(unsigned w) { return __builtin_bit_cast(float, w << 16); }
__device__ __forceinline__ float bfhi(unsigned w) { return __builtin_bit_cast(float, w & 0xffff0000u); }

__device__ __forceinline__ void p0_transpose_item(const float* W, int N, bf16* WT, int KT, int kt_off, const float* gk, bool permute, bool p32, LAS float* scr, int item, int lane) {
    const int nblk = N / 32, kb = item / nblk, nb = item % nblk, k0 = 64 * kb, n0 = 32 * nb;
    float tv[32];
#pragma unroll
    for (int i = 0; i < 32; ++i) tv[i] = __builtin_nontemporal_load(W + (size_t)(k0 + 2 * i + (lane >> 5)) * N + n0 + (lane & 31));
    if (gk) {
#pragma unroll
        for (int i = 0; i < 32; ++i) tv[i] *= gk[k0 + 2 * i + (lane >> 5)];
    }
#pragma unroll
    for (int i = 0; i < 32; ++i) scr[(2 * i + (lane >> 5)) * 33 + (lane & 31)] = tv[i];
    LDS_WAIT(); asm volatile("" ::: "memory");
    int rb = n0;
    if (permute) { const int pn = nb >> 3, w = nb & 7; rb = 256 * pn + 128 * (w & 1) + 32 * (w >> 1); }
    const int c = lane & 7;
#pragma unroll
    for (int j = 0; j < 4; ++j) { const int n = (lane >> 3) + 8 * j; const LAS float* s = scr + (8 * c) * 33 + n;
        v4u o; o.x = pk2(s[0 * 33], s[1 * 33]); o.y = pk2(s[2 * 33], s[3 * 33]); o.z = pk2(s[4 * 33], s[5 * 33]); o.w = pk2(s[6 * 33], s[7 * 33]);
        const int R = rb + (p32 ? pg8::perm32inv(n) : n);
        *(GAS v4u*)(WT + pg8::tiled_off(R, 64 * (kt_off + kb) + 8 * c, KT)) = o; }
    LDS_WAIT(); asm volatile("" ::: "memory");
}
__device__ __forceinline__ void p0_fold_item(const Frame& F, int item, int lane) {
    const int g = item >> 9, r = item & 511, c0 = 8 * (r >> 5) + 4 * (lane >> 5), n = 32 * (r & 31) + (lane & 31);
    const float* pw = F.pool_w + ((size_t)g * 128 + c0) * 128; const float* ps = F.pool_s + 128 * g; const float* wo = F.w_out + (size_t)(128 * g) * D + n;
    float a0 = 0.f, a1 = 0.f, a2 = 0.f, a3 = 0.f;
#pragma unroll 8
    for (int d = 0; d < 128; d += 4) {
        const f32x4 p0 = *(const f32x4*)(pw + d), p1 = *(const f32x4*)(pw + 128 + d), p2 = *(const f32x4*)(pw + 256 + d), p3 = *(const f32x4*)(pw + 384 + d), s4 = *(const f32x4*)(ps + d);
#pragma unroll
        for (int e = 0; e < 4; ++e) { const float w = s4[e] * wo[(size_t)(d + e) * D]; a0 += p0[e] * w; a1 += p1[e] * w; a2 += p2[e] * w; a3 += p3[e] * w; }
    }
    *(GAS unsigned long long*)(F.Wout_t + pg8::tiled_off((n & ~31) + pg8::perm32inv(n & 31), 128 * g + c0, 16)) = (unsigned long long)pk2(a0, a1) | ((unsigned long long)pk2(a2, a3) << 32);
}
__device__ __forceinline__ void p0_prologue(Frame& F) {
    LAS float* scr = (LAS float*)(F.lds + RING_OFF + F.wave * 16384);
    const int gw = F.vcu * NWAVES + F.wave, NGW = F.G * NWAVES;
    constexpr int I_IN = (D / 64) * (NIN / 32), I_OUT = (512 / 64) * (D / 32), I_UP = (D / 64) * (FF / 32), I_DN = (FF / 64) * (D / 32), I_FOLD = 4 * 16 * 32;
    constexpr int NITEMS = I_IN + I_OUT + I_UP + I_DN + I_FOLD;
    for (int it = gw; it < NITEMS; it += NGW) {
        int r = it;
        if (r < I_FOLD) { p0_fold_item(F, r, F.lane); continue; } r -= I_FOLD;
        const float* W; const float* gk; bf16* WT; int N, KT, kt_off; bool perm, p32 = true;
        if (r < I_IN) { W = F.w_in; N = NIN; WT = F.Win_t; KT = 16; kt_off = 0; gk = F.g1; perm = true; }
        else if ((r -= I_IN) < I_OUT) { W = F.w_out + (size_t)512 * D; N = D; WT = F.Wout_t; KT = 16; kt_off = 8; gk = nullptr; perm = false; }
        else if ((r -= I_OUT) < I_UP) { W = F.w_up; N = FF; WT = F.Wup_t; KT = 16; kt_off = 0; gk = F.g2; perm = false; }
        else { r -= I_UP; W = F.w_dn; N = D; WT = F.Wdn_t; KT = 64; kt_off = 0; gk = nullptr; perm = false; p32 = false; }
        p0_transpose_item(W, N, WT, KT, kt_off, gk, perm, p32, scr, r, F.lane);
    }
    {
        const int rsel = F.lane >> 4, j8 = 8 * (F.lane & 15);
        for (int m0 = 8 * gw; m0 < M; m0 += 8 * NGW) {
            f32x4 v[2][16];
#pragma unroll
            for (int q = 0; q < 2; ++q) { const GAS f32x4* xr = (const GAS f32x4*)(F.x + (size_t)(m0 + 4 * q + rsel) * D + j8);
#pragma unroll
                for (int i = 0; i < 8; ++i) { v[q][2 * i] = __builtin_nontemporal_load(xr + 32 * i); v[q][2 * i + 1] = __builtin_nontemporal_load(xr + 32 * i + 1); } }
#pragma unroll
            for (int q = 0; q < 2; ++q) { float s = 0.f; const int row = m0 + 4 * q + rsel;
#pragma unroll
                for (int i = 0; i < 16; ++i) s += (v[q][i].x * v[q][i].x + v[q][i].y * v[q][i].y) + (v[q][i].z * v[q][i].z + v[q][i].w * v[q][i].w);
                s += __builtin_bit_cast(float, __builtin_amdgcn_update_dpp(0, __builtin_bit_cast(int, s), 0xB1, 0xF, 0xF, false));
                s += __builtin_bit_cast(float, __builtin_amdgcn_update_dpp(0, __builtin_bit_cast(int, s), 0x4E, 0xF, 0xF, false));
                s += __builtin_bit_cast(float, __builtin_amdgcn_update_dpp(0, __builtin_bit_cast(int, s), 0x124, 0xF, 0xF, false));
                s += __builtin_bit_cast(float, __builtin_amdgcn_update_dpp(0, __builtin_bit_cast(int, s), 0x128, 0xF, 0xF, false));
                const float ms = s * (1.f / D) + NORM_EPS, rstd = __builtin_amdgcn_rsqf(ms);
                if ((F.lane & 15) == 0) F.RN1[row] = __builtin_sqrtf(ms);
#pragma unroll
                for (int i = 0; i < 8; ++i) { const f32x4 a = v[q][2 * i] * rstd, b = v[q][2 * i + 1] * rstd; v4u o; o.x = pk2(a.x, a.y); o.y = pk2(a.z, a.w); o.z = pk2(b.x, b.y); o.w = pk2(b.z, b.w);
                    *(GAS v4u*)(F.XN + pg8::tiled_off(row, j8 + 128 * i, 16)) = o; } }
        }
    }
}

__device__ __forceinline__ int t5_bucket_dev(int dist) {
    if (dist < 16) return dist;
    int l = 16 + (int)(__builtin_log2f((float)dist * (1.0f / 16.0f)) * (16.0f / 7.0f));
    return l < 31 ? l : 31;
}
#ifndef MK_KDMA_AUX
#define MK_KDMA_AUX 2
#endif
#ifndef MK_VDMA_AUX
#define MK_VDMA_AUX 2
#endif
namespace mixer {
typedef float f32x16 __attribute__((ext_vector_type(16)));
typedef short s16x4 __attribute__((ext_vector_type(4)));
typedef short v4i16_t __attribute__((ext_vector_type(4)));
constexpr int K_OFF = 0, V_OFF = 49152, OST_OFF = 98304, TBL_OFF = 131584, TBL_STRIDE = 192, WSF_OFF = TBL_OFF + 4 * TBL_STRIDE * 4, RB_OFF = WSF_OFF + 8 * 256, NEG_OFF = RB_OFF + 1024;
static_assert(NEG_OFF + 256 <= LDS_BYTES && TBL_OFF >= MISC_OFF + 128, "mixer LDS map");
constexpr float NEG_BIG = -1.0e30f;

__device__ __forceinline__ unsigned cvtpk(float lo, float hi) { typedef float f2 __attribute__((ext_vector_type(2))); typedef __bf16 b2 __attribute__((ext_vector_type(2))); f2 v = {lo, hi}; b2 b = __builtin_convertvector(v, b2); return __builtin_bit_cast(unsigned, b); }
__device__ __forceinline__ s16x4 vtr(const LAS unsigned char* p) { return __builtin_bit_cast(s16x4, __builtin_amdgcn_ds_read_tr16_b64_v4i16((LAS v4i16_t*)p)); }
__device__ __forceinline__ int crow(int r, int hi) { return (r & 3) + 8 * (r >> 2) + 4 * hi; }

__device__ __forceinline__ float softmax_ref(const Frame& F) {
    float mq = __builtin_fabsf(F.qg[F.lane]), mk = __builtin_fabsf(F.kg[F.lane]);
    const f32x4 bv = *(const f32x4*)(F.rel_bias + 4 * F.lane);
    float mb = __builtin_fmaxf(__builtin_fmaxf(__builtin_fabsf(bv[0]), __builtin_fabsf(bv[1])), __builtin_fmaxf(__builtin_fabsf(bv[2]), __builtin_fabsf(bv[3])));
    mq = wave_max(mq); mk = wave_max(mk); mb = wave_max(mb);
    return (pg8::C2 * 64.0f * mq * mk + mb * LOG2E) * 1.02f + 0.25f;
}

struct ItemP { int b, h, d, r, c, ps, base; };
template <bool FINAL> __device__ __forceinline__ bool item_decode(const Frame& F, int i, ItemP& p) {
    int bh;
    if (!FINAL) {
        if (F.G == 256) {
            if (i >= 8) return false;
            const int xg = F.vcu >> 5, cu = F.vcu & 31;
            if (i < 4) { bh = 4 * xg + (cu >> 3); p.d = 4; p.r = (cu >> 1) & 3; p.c = 4 * (cu & 1) + i; p.ps = 0; p.base = 4 * i; }
            else { const int rho = 2 * cu + ((i - 4) >> 1); bh = 4 * xg + (rho >> 4); p.d = 16; p.r = rho & 15; p.c = (i - 4) & 1; p.ps = 1; p.base = 4 * ((i - 4) & 1); }
        } else {
            const int L = (int)blockIdx.x + i * F.G; if (L >= 2048) return false; bh = L >> 6; const int sub = L & 63, s = sub & 31; p.base = 0;
            if ((sub >> 5) == 0) { p.d = 4; p.r = s >> 3; p.c = s & 7; p.ps = 0; } else { p.d = 16; p.r = s >> 1; p.c = s & 1; p.ps = 1; }
        }
    } else {
        if (F.G == 256) { if (i >= 4) return false; const int cu = F.vcu & 31; bh = 4 * (F.vcu >> 5) + (cu >> 3); p.c = 4 * (cu & 7) + i; p.base = 4 * i; }
        else { const int L = (int)blockIdx.x + i * F.G; if (L >= 1024) return false; bh = L >> 5; p.c = L & 31; p.base = 0; }
        p.d = 1; p.r = 0; p.ps = 0;
    }
    p.b = bh >> 3; p.h = bh & 7; return true;
}
__device__ __forceinline__ void issue_k(const Frame& F, const ItemP& p) {
    const int lane = F.lane, w = F.wave, kpos0 = 256 * p.c - 128;
    const bf16* Kh = F.K + (size_t)(p.b * 8 + p.h) * 8192 * 64;
    const int cs = ((lane & 7) ^ (lane >> 3)) * 8;
#pragma unroll
    for (int i = 0; i < 6; ++i) { if (i < 2 && p.base != 0) continue;
        int pos = kpos0 + i * 64 + 8 * w + (lane >> 3); pos = pos < 0 ? 0 : pos;
        const int slot = (p.base + i) % 6;
        __builtin_amdgcn_global_load_lds((const unsigned*)(Kh + (size_t)(p.r + p.d * pos) * 64 + cs), (LAS unsigned*)(F.lds + K_OFF + slot * 8192 + w * 1024), 16, 0, MK_KDMA_AUX); }
}
__device__ __forceinline__ void issue_v(const Frame& F, const ItemP& p) {
    const int lane = F.lane, w = F.wave, kpos0 = 256 * p.c - 128;
    const bf16* Vh = F.V + (size_t)(p.b * 8 + p.h) * 8192 * 64;
    const int cs = ((lane & 7) ^ (((lane >> 4) & 1) << 2)) * 8;
#pragma unroll
    for (int i = 0; i < 6; ++i) { if (i < 2 && p.base != 0) continue;
        int pos = kpos0 + i * 64 + 8 * w + (lane >> 3); pos = pos < 0 ? 0 : pos;
        const int slot = (p.base + i) % 6;
        __builtin_amdgcn_global_load_lds((const unsigned*)(Vh + (size_t)(p.r + p.d * pos) * 64 + cs), (LAS unsigned*)(F.lds + V_OFF + slot * 8192 + w * 1024), 16, 0, MK_VDMA_AUX); }
}
__device__ __forceinline__ void build_table(const Frame& F, const ItemP& p, float MB2) {
    LAS float* tbl = (LAS float*)(F.lds + TBL_OFF); const LAS float* rb = (const LAS float*)(F.lds + RB_OFF);
    for (int idx = F.tid; idx < 4 * TBL_STRIDE; idx += NWAVES * 64) {
        const int m = idx / TBL_STRIDE, i = idx - m * TBL_STRIDE, dist = 160 - (i + ((4 - m) & 3));
        float v = NEG_BIG;
        if (dist >= 0 && dist <= 128) v = rb[t5_bucket_dev(dist * p.d) * NH + p.h] * LOG2E - MB2;
        tbl[idx] = v;
    }
}
__device__ __forceinline__ void load_q(const Frame& F, const ItemP& p, bf16x8 (&q)[4]) {
    const int r32 = F.lane & 31, hi = F.lane >> 5, qpos = 256 * p.c + 32 * F.wave + r32;
    const bf16* qrow = F.Q + ((size_t)(p.b * 8 + p.h) * 8192 + (size_t)(p.r + p.d * qpos)) * 64 + hi * 8;
#pragma unroll
    for (int d0 = 0; d0 < 4; ++d0) q[d0] = *(const bf16x8*)(qrow + d0 * 16);
}

template <bool FINAL>
__device__ __forceinline__ void attn_phase(Frame& F, float MB2) {
    const int lane = F.lane, w = F.wave, r32 = lane & 31, hi = lane >> 5;
    LAS unsigned char* lds = F.lds;
    if (F.tid < 256) ((LAS float*)(lds + RB_OFF))[F.tid] = F.rel_bias[F.tid];
    if (F.tid < 64) ((LAS float*)(lds + NEG_OFF))[F.tid] = NEG_BIG;
    ItemP cur, nxt; nxt.b = nxt.h = nxt.d = nxt.r = nxt.c = nxt.ps = nxt.base = 0;
    bool has = item_decode<FINAL>(F, 0, cur);
    bf16x8 qr[4], qn[4];
#pragma unroll
    for (int d0 = 0; d0 < 4; ++d0) { qr[d0] = (bf16x8){0, 0, 0, 0, 0, 0, 0, 0}; qn[d0] = qr[d0]; }
    __syncthreads();
    if (has) { issue_k(F, cur); build_table(F, cur, MB2); load_q(F, cur, qr); }
    const int m4 = r32 & 3;
    const LAS unsigned char* tb = lds + TBL_OFF + m4 * (TBL_STRIDE * 4) + 4 * ((32 - r32 + 4 * hi) - ((4 - m4) & 3));
    const LAS unsigned char* kb_l = lds + K_OFF + r32 * 128;
    int kx[4];
#pragma unroll
    for (int d0 = 0; d0 < 4; ++d0) kx[d0] = ((2 * d0 + hi) ^ (r32 & 7)) * 16;
    const LAS unsigned char* vb_l = lds + V_OFF + ((lane >> 4) & 1) * 32 + (lane & 3) * 8 + (4 * hi + ((lane & 15) >> 2)) * 128;
    const int vsw = ((lane >> 3) & 1) * 64;
    const LAS unsigned char* negb = lds + NEG_OFF;
    LAS bf16* stg = (LAS bf16*)(lds + OST_OFF + w * 4096);
    LAS float* wsf = (LAS float*)(lds + WSF_OFF + w * 256);
    for (int it = 0; has; ++it) {
        const int c = cur.c;
        __syncthreads();
        issue_v(F, cur);
        bf16x8 pa[5][2]; float lsum = 0.f;
        f32x16 sc, sn;
#define QK_INIT(S, kb) do { const int k0_ = 32 * w + 32 * (kb); const LAS unsigned char* tbk_ = (c == 0 && k0_ < 128) ? negb : tb + 4 * 32 * (kb); \
            _Pragma("unroll") for (int q4 = 0; q4 < 4; ++q4) { const f32x4 t4 = *(const LAS f32x4*)(tbk_ + 4 * (8 * q4)); S[4 * q4] = t4[0]; S[4 * q4 + 1] = t4[1]; S[4 * q4 + 2] = t4[2]; S[4 * q4 + 3] = t4[3]; } } while (0)
#define K_FRAGS(KF, kb) do { const int k0_ = 32 * w + 32 * (kb); const LAS unsigned char* kp_ = kb_l + ((cur.base + (k0_ >> 6)) % 6) * 8192 + ((k0_ >> 5) & 1) * 4096; \
            _Pragma("unroll") for (int d0 = 0; d0 < 4; ++d0) KF[d0] = *(const LAS bf16x8*)(kp_ + kx[d0]); } while (0)
        bf16x8 kf[4];
        QK_INIT(sc, 0); K_FRAGS(kf, 0);
#pragma unroll
        for (int d0 = 0; d0 < 4; ++d0) sc = __builtin_amdgcn_mfma_f32_32x32x16_bf16(kf[d0], qr[d0], sc, 0, 0, 0);
#pragma unroll
        for (int kb = 0; kb < 5; ++kb) {
            if (kb < 4) { QK_INIT(sn, kb + 1); K_FRAGS(kf, kb + 1); }
            unsigned pw[8];
            __builtin_amdgcn_sched_barrier(0);
#pragma unroll
            for (int g = 0; g < 4; ++g) {
                if (kb < 4) sn = __builtin_amdgcn_mfma_f32_32x32x16_bf16(kf[g], qr[g], sn, 0, 0, 0);
                const float e0 = __builtin_amdgcn_exp2f(sc[4 * g]), e1 = __builtin_amdgcn_exp2f(sc[4 * g + 1]), e2 = __builtin_amdgcn_exp2f(sc[4 * g + 2]), e3 = __builtin_amdgcn_exp2f(sc[4 * g + 3]);
                lsum += (e0 + e1) + (e2 + e3);
                pw[2 * g] = cvtpk(e0, e1); pw[2 * g + 1] = cvtpk(e2, e3);
                asm volatile("" : "+v"(pw[2 * g]), "+v"(pw[2 * g + 1]), "+v"(lsum));
                __builtin_amdgcn_sched_barrier(0);
            }
            pa[kb][0] = __builtin_bit_cast(bf16x8, (v4u){pw[0], pw[1], pw[2], pw[3]}); pa[kb][1] = __builtin_bit_cast(bf16x8, (v4u){pw[4], pw[5], pw[6], pw[7]});
            if (kb < 4) sc = sn;
        }
#undef QK_INIT
#undef K_FRAGS
        __syncthreads();
        const bool has_next = item_decode<FINAL>(F, it + 1, nxt);
        if (has_next) { issue_k(F, nxt); build_table(F, nxt, MB2); load_q(F, nxt, qn); }
        f32x16 o0 = {}, o1 = {};
        s16x4 vA[8], vB[8];
#define V_READS(VR, kb) do { const int k0_ = 32 * w + 32 * (kb); const unsigned vp_ = (unsigned)(uintptr_t)(vb_l + ((cur.base + (k0_ >> 6)) % 6) * 8192 + ((k0_ >> 4) & 3) * 2048); \
            const unsigned vd0_ = vp_ + (unsigned)vsw, vd1_ = vp_ + (unsigned)(64 ^ vsw); \
            asm volatile("ds_read_b64_tr_b16 %0, %1" : "=&v"(VR[0]) : "v"(vd0_) : "memory"); asm volatile("ds_read_b64_tr_b16 %0, %1 offset:1024" : "=&v"(VR[1]) : "v"(vd0_) : "memory"); \
            asm volatile("ds_read_b64_tr_b16 %0, %1 offset:2048" : "=&v"(VR[2]) : "v"(vd0_) : "memory"); asm volatile("ds_read_b64_tr_b16 %0, %1 offset:3072" : "=&v"(VR[3]) : "v"(vd0_) : "memory"); \
            asm volatile("ds_read_b64_tr_b16 %0, %1" : "=&v"(VR[4]) : "v"(vd1_) : "memory"); asm volatile("ds_read_b64_tr_b16 %0, %1 offset:1024" : "=&v"(VR[5]) : "v"(vd1_) : "memory"); \
            asm volatile("ds_read_b64_tr_b16 %0, %1 offset:2048" : "=&v"(VR[6]) : "v"(vd1_) : "memory"); asm volatile("ds_read_b64_tr_b16 %0, %1 offset:3072" : "=&v"(VR[7]) : "v"(vd1_) : "memory"); } while (0)
#define V_WAIT(VR) do { asm volatile("s_waitcnt lgkmcnt(0)" : "+v"(VR[0]), "+v"(VR[1]), "+v"(VR[2]), "+v"(VR[3]), "+v"(VR[4]), "+v"(VR[5]), "+v"(VR[6]), "+v"(VR[7]) :: "memory"); __builtin_amdgcn_sched_barrier(0); } while (0)
#define VF(VR, i) ((bf16x8){VR[i][0], VR[i][1], VR[i][2], VR[i][3], VR[(i) + 1][0], VR[(i) + 1][1], VR[(i) + 1][2], VR[(i) + 1][3]})
#define PV_MMA(VR, kb) do { o0 = __builtin_amdgcn_mfma_f32_32x32x16_bf16(pa[kb][0], VF(VR, 0), o0, 0, 0, 0); o0 = __builtin_amdgcn_mfma_f32_32x32x16_bf16(pa[kb][1], VF(VR, 2), o0, 0, 0, 0); \
            o1 = __builtin_amdgcn_mfma_f32_32x32x16_bf16(pa[kb][0], VF(VR, 4), o1, 0, 0, 0); o1 = __builtin_amdgcn_mfma_f32_32x32x16_bf16(pa[kb][1], VF(VR, 6), o1, 0, 0, 0); } while (0)
        V_READS(vA, 0); V_WAIT(vA);
        V_READS(vB, 1); PV_MMA(vA, 0); V_WAIT(vB);
        V_READS(vA, 2); PV_MMA(vB, 1); V_WAIT(vA);
        V_READS(vB, 3); PV_MMA(vA, 2); V_WAIT(vB);
        V_READS(vA, 4); PV_MMA(vB, 3); V_WAIT(vA);
        PV_MMA(vA, 4);
#undef V_READS
#undef V_WAIT
#undef VF
#undef PV_MMA
        lsum += __shfl_xor(lsum, 32);
#pragma unroll
        for (int e = 0; e < 16; ++e) { const int orow = crow(e, hi); stg[orow * 64 + r32] = (bf16)f2bf(o0[e]); stg[orow * 64 + 32 + r32] = (bf16)f2bf(o1[e]); }
        if (hi == 0) wsf[r32] = lsum;
        LDS_WAIT(); asm volatile("" ::: "memory");
        const int qbase = 256 * c + 32 * w, b = cur.b, h = cur.h, d = cur.d, r = cur.r, ps = cur.ps;
        v4u pfa[4], pfb[4]; float pfl[4];
        if (FINAL) {
#pragma unroll
            for (int i = 0; i < 4; ++i) {
                const int rl = i * 8 + (lane >> 3), ch = lane & 7;
                const size_t row = (size_t)b * 8192 + (size_t)(r + d * (qbase + rl));
                pfa[i] = __builtin_nontemporal_load((const GAS v4u*)(F.PO + row * AW + h * 64 + ch * 8)); pfb[i] = __builtin_nontemporal_load((const GAS v4u*)(F.PO + ((size_t)M + row) * AW + h * 64 + ch * 8));
                pfl[i] = F.PL[row * NH + h] + F.PL[((size_t)M + row) * NH + h];
            }
        }
#pragma unroll
        for (int i = 0; i < 4; ++i) {
            const int rl = i * 8 + (lane >> 3), ch = lane & 7;
            const size_t row = (size_t)b * 8192 + (size_t)(r + d * (qbase + rl));
            const v4u ov = *(const LAS v4u*)(stg + rl * 64 + ch * 8);
            if (!FINAL) {
                *(GAS v4u*)(F.PO + ((size_t)ps * M + row) * AW + h * 64 + ch * 8) = ov;
                if (ch == 0) F.PL[((size_t)ps * M + row) * NH + h] = wsf[rl];
            } else {
                const v4u a = pfa[i], bq = pfb[i];
                const float l = wsf[rl] + pfl[i];
                const float rl_ = 1.0f / l;
                v4u o;
                o.x = pk2((bflo(ov.x) + bflo(a.x) + bflo(bq.x)) * rl_, (bfhi(ov.x) + bfhi(a.x) + bfhi(bq.x)) * rl_);
                o.y = pk2((bflo(ov.y) + bflo(a.y) + bflo(bq.y)) * rl_, (bfhi(ov.y) + bfhi(a.y) + bfhi(bq.y)) * rl_);
                o.z = pk2((bflo(ov.z) + bflo(a.z) + bflo(bq.z)) * rl_, (bfhi(ov.z) + bfhi(a.z) + bfhi(bq.z)) * rl_);
                o.w = pk2((bflo(ov.w) + bflo(a.w) + bflo(bq.w)) * rl_, (bfhi(ov.w) + bfhi(a.w) + bfhi(bq.w)) * rl_);
                *(GAS v4u*)(F.MIX + pg8::tiled_off((int)row, PW + h * 64 + ch * 8, 16)) = o;
            }
        }
        cur = nxt; has = has_next;
#pragma unroll
        for (int d0 = 0; d0 < 4; ++d0) qr[d0] = qn[d0];
    }
    __syncthreads();
}

__device__ __forceinline__ void pool_item(Frame& F, int item) {
    const int lane = F.lane, g = lane >> 4;
    const float rw = g == 0 ? 0.5f : (g == 1 ? 0.25f : (g == 2 ? 0.125f : 0.0625f));
#pragma unroll 1
    for (int half = 0; half < 4; ++half) {
        const int row0 = item * 128 + F.wave * 16 + half * 4, t0 = row0 & 8191;
        const bf16* Up = F.U + (size_t)row0 * PW + lane * 8;
        v4u raw[19];
#pragma unroll
        for (int j = 0; j < 19; ++j) { if (j >= 15 || t0 >= 15 - j) raw[j] = *(const GAS v4u*)(Up + (long)(j - 15) * PW); else raw[j] = (v4u){0u, 0u, 0u, 0u}; }
        v4u outw[4];
#pragma unroll
        for (int wd = 0; wd < 4; ++wd) {
            float lo[19], hi[19];
#pragma unroll
            for (int j = 0; j < 19; ++j) { const unsigned w = wd == 0 ? raw[j].x : (wd == 1 ? raw[j].y : (wd == 2 ? raw[j].z : raw[j].w)); lo[j] = bflo(w); hi[j] = bfhi(w); }
#pragma unroll
            for (int k = 0; k < 4; ++k) {
                const int j = k + 15;
                const float l2 = lo[j] + lo[j - 1], l4 = l2 + (lo[j - 2] + lo[j - 3]), l8 = l4 + ((lo[j - 4] + lo[j - 5]) + (lo[j - 6] + lo[j - 7]));
                const float l16 = l8 + (((lo[j - 8] + lo[j - 9]) + (lo[j - 10] + lo[j - 11])) + ((lo[j - 12] + lo[j - 13]) + (lo[j - 14] + lo[j - 15])));
                const float h2 = hi[j] + hi[j - 1], h4 = h2 + (hi[j - 2] + hi[j - 3]), h8 = h4 + ((hi[j - 4] + hi[j - 5]) + (hi[j - 6] + hi[j - 7]));
                const float h16 = h8 + (((hi[j - 8] + hi[j - 9]) + (hi[j - 10] + hi[j - 11])) + ((hi[j - 12] + hi[j - 13]) + (hi[j - 14] + hi[j - 15])));
                const float sl = g == 0 ? l2 : (g == 1 ? l4 : (g == 2 ? l8 : l16)), sh = g == 0 ? h2 : (g == 1 ? h4 : (g == 2 ? h8 : h16));
                float rc = rw;
                if (t0 + k < 15) { const int win = 2 << g, cnt = (t0 + k + 1 < win) ? t0 + k + 1 : win; rc = 1.0f / (float)cnt; }
                const unsigned o = pk2(sl * rc - lo[j], sh * rc - hi[j]);
                if (wd == 0) outw[k].x = o; else if (wd == 1) outw[k].y = o; else if (wd == 2) outw[k].z = o; else outw[k].w = o;
            }
        }
#pragma unroll
        for (int k = 0; k < 4; ++k) *(GAS v4u*)(F.MIX + pg8::tiled_off(row0 + k, lane * 8, 16)) = outw[k];
    }
}

__device__ __forceinline__ void phase_2a(Frame& F) { const float MB2 = softmax_ref(F); attn_phase<false>(F, MB2); }
__device__ __forceinline__ void phase_2b(Frame& F) {
    const float MB2 = softmax_ref(F); attn_phase<true>(F, MB2);
    for (int it = F.vcu; it < M / 128; it += F.G) pool_item(F, it);
}
}

struct Args { const float* in[12]; float* out; unsigned char* ws; int ph_lo, ph_hi, li, pad; };
__global__ void __launch_bounds__(NWAVES * 64, 2) mk_fwd(Args args) {
    extern __shared__ __attribute__((aligned(16))) unsigned char lds[];
    Frame F;
    F.lds = (LAS unsigned char*)lds;
    F.MISC = (volatile LAS unsigned*)(F.lds + MISC_OFF);
    F.tid = threadIdx.x; F.lane = F.tid & 63; F.wave = __builtin_amdgcn_readfirstlane(F.tid >> 6);
    F.G = gridDim.x; { const int bx = blockIdx.x; F.vcu = (F.G % 8 == 0) ? (bx % 8) * (F.G / 8) + bx / 8 : bx; }
    unsigned char* ws = args.ws;
    F.ctl = (gu32*)(ws + WS_CTL);
    F.x = args.in[0]; F.g1 = args.in[1]; F.w_in = args.in[2]; F.pool_w = args.in[3]; F.pool_s = args.in[4]; F.qg = args.in[5]; F.kg = args.in[6]; F.rel_bias = args.in[7];
    F.w_out = args.in[8]; F.g2 = args.in[9]; F.w_up = args.in[10]; F.w_dn = args.in[11]; F.out = args.out;
    F.Win_t = (bf16*)(ws + WS_WIN); F.Wout_t = (bf16*)(ws + WS_WOUT); F.Wup_t = (bf16*)(ws + WS_WUP); F.Wdn_t = (bf16*)(ws + WS_WDN);
    F.XN = (bf16*)(ws + WS_XN); F.U = (bf16*)(ws + WS_U); F.Q = (bf16*)(ws + WS_Q); F.K = (bf16*)(ws + WS_K); F.V = (bf16*)(ws + WS_V); F.PO = (bf16*)(ws + WS_PO);
    F.MIX = (bf16*)(ws + WS_MIX); F.HB = (bf16*)(ws + WS_HB); F.FFB = (bf16*)(ws + WS_FF); F.RSS = (float*)(ws + WS_RSS); F.PL = (float*)(ws + WS_PL); F.RN1 = (float*)(ws + WS_RN1);
    for (int u = F.tid; u < (LDS_BYTES - LDSCTL_OFF) / 4; u += NWAVES * 64) ((LAS unsigned*)(F.lds + LDSCTL_OFF))[u] = 0u;
    __syncthreads();
    XcdBarrier bar; bar.bar = (unsigned*)(F.ctl + CW_BAR); bar.x = 0; bar.st = nullptr;
    if (!MK_PER_PHASE) bar = xcd_barrier_post((unsigned*)(F.ctl + CW_BAR), F.MISC + 8);
    const int lo = args.ph_lo, hi = args.ph_hi;
#define IN(k) (lo <= (k) && (k) < hi)
#ifndef MK_DUP_PHASE
#define MK_DUP_PHASE (-1)
#endif
#define BOTH(k) (IN(k) && IN((k) + 1))
#define GRID_BAR() do { if (!MK_PER_PHASE) xcd_barrier(bar); } while (0)

    if (IN(0)) { p0_prologue(F); if (BOTH(0)) GRID_BAR(); }
#if MK_DUP_PHASE == 0
    p0_prologue(F); GRID_BAR();
#endif
#define RUN_P1() do { pg8::Gemm g{F.XN, F.Win_t, M, NIN, D}; pg8::StaticOrder S; S.init(M, NIN, F.G, (int)blockIdx.x); \
        pg8::EpiInProj E{F.U, F.Q, F.K, F.V, F.qg, F.kg}; \
        pg8::gemm_phase<pg8::EpiInProj, pg8::StaticOrder, true, true, true, MK_P1_AUXA>(F.lds + RING_OFF, g, S, E); } while (0)
#define RUN_P4() do { pg8::Gemm g{F.MIX, F.Wout_t, M, D, D}; pg8::StaticOrder S; S.init(M, D, F.G, (int)blockIdx.x); \
        pg8::EpiOut E{F.XN, F.RN1, F.HB, F.RSS}; \
        pg8::gemm_phase<pg8::EpiOut, pg8::StaticOrder, true, true, true, MK_P4_AUXA>(F.lds + RING_OFF, g, S, E); } while (0)
#ifndef MK_MLP_PARTS
#define MK_MLP_PARTS 1
#endif
#define MH (M / MK_MLP_PARTS)
#ifndef MK_P6_AUXA
#define MK_P6_AUXA 2
#endif
#ifndef MK_P6_AUXB
#define MK_P6_AUXB 0
#endif
#ifndef MK_P4_AUXA
#define MK_P4_AUXA 0
#endif
#ifndef MK_P5_AUXA
#define MK_P5_AUXA 0
#endif
#ifndef MK_P1_AUXA
#define MK_P1_AUXA 0
#endif
#define RUN_P5(hf) do { pg8::Gemm g{F.HB + (size_t)(hf) * MH * D, F.Wup_t, MH, FF, D}; pg8::StaticOrder S; S.init(MH, FF, F.G, (int)blockIdx.x); \
        pg8::EpiUp E{F.FFB + (size_t)(hf) * MH * FF}; \
        pg8::gemm_phase<pg8::EpiUp, pg8::StaticOrder, true, true, true, MK_P5_AUXA>(F.lds + RING_OFF, g, S, E); } while (0)
#define RUN_P6(hf) do { pg8::Gemm g{F.FFB + (size_t)(hf) * MH * FF, F.Wdn_t, MH, D, FF}; pg8::StaticOrder S; S.init(MH, D, F.G, (int)blockIdx.x); \
        pg8::EpiDown E{F.HB + (size_t)(hf) * MH * D, F.RSS + (size_t)(hf) * MH * 16, F.out + (size_t)(hf) * MH * D}; \
        pg8::gemm_phase<pg8::EpiDown, pg8::StaticOrder, true, true, true, MK_P6_AUXA, MK_P6_AUXB>(F.lds + RING_OFF, g, S, E); } while (0)
    if (IN(1)) { RUN_P1(); if (BOTH(1)) GRID_BAR(); }
#if defined(MK_EXTRA_BARS)
    for (int eb = 0; eb < 16; ++eb) GRID_BAR();
#endif
#if MK_DUP_PHASE == 1
    RUN_P1(); GRID_BAR();
#endif
    if (IN(2)) { mixer::phase_2a(F); if (BOTH(2)) GRID_BAR(); }
#if MK_DUP_PHASE == 2
    mixer::phase_2a(F); GRID_BAR();
#endif
    if (IN(3)) { mixer::phase_2b(F); if (BOTH(3)) GRID_BAR(); }
#if MK_DUP_PHASE == 3
    mixer::phase_2b(F); GRID_BAR();
#endif
    if (IN(4)) { RUN_P4(); if (BOTH(4)) GRID_BAR(); }
#if MK_DUP_PHASE == 4
    RUN_P4(); GRID_BAR();
#endif
    if (IN(5)) { RUN_P5(0); if (BOTH(5)) GRID_BAR(); }
#if MK_DUP_PHASE == 5
    RUN_P5(0); GRID_BAR();
#endif
    if (IN(6)) { RUN_P6(0); if (BOTH(6) && MK_PER_PHASE) GRID_BAR(); }
#if MK_DUP_PHASE == 6
    RUN_P6(0); GRID_BAR();
#endif
#if MK_MLP_PARTS == 2
    if (IN(7)) { RUN_P5(1); if (BOTH(7)) GRID_BAR(); }
    if (IN(8)) { RUN_P6(1); }
#endif
#undef IN
#undef BOTH
#undef GRID_BAR
}

extern "C" void kernel_launch(void* const* d_in, const int* in_sizes, int n_in, void* d_out, int out_size, void* d_ws, size_t ws_size, hipStream_t stream) {
    static int grid = 0;
    if (grid == 0) {
        if (n_in != 12 || in_sizes[0] != M * D || out_size != M * D || ws_size < WS_END) { fprintf(stderr, "kernel_launch: unexpected shapes (n_in %d, in0 %d, out %d, ws %zu); nothing launched\n", n_in, n_in > 0 ? in_sizes[0] : -1, out_size, ws_size); grid = -1; return; }
        int dev = 0, cus = 0;
        if (hipGetDevice(&dev) != hipSuccess || hipDeviceGetAttribute(&cus, hipDeviceAttributeMultiprocessorCount, dev) != hipSuccess) { grid = -1; return; }
        if (hipFuncSetAttribute((const void*)mk_fwd, hipFuncAttributeMaxDynamicSharedMemorySize, LDS_BYTES) != hipSuccess) { fprintf(stderr, "kernel_launch: hipFuncSetAttribute failed\n"); grid = -1; return; }
        int per_cu = 0;
        if (hipOccupancyMaxActiveBlocksPerMultiprocessor(&per_cu, (const void*)mk_fwd, NWAVES * 64, LDS_BYTES) != hipSuccess || per_cu < 1) fprintf(stderr, "kernel_launch: occupancy query says %d\n", per_cu);
        (void)hipGetLastError();
        grid = cus;
    }
    if (grid < 0) return;
    if (hipMemsetAsync((char*)d_ws + WS_CTL, 0, 65536, stream) != hipSuccess) return;
    Args a{};
    for (int i = 0; i < 12; ++i) a.in[i] = (const float*)d_in[i];
    a.out = (float*)d_out; a.ws = (unsigned char*)d_ws;
#if MK_PER_PHASE
    for (int li = 0; li < NPHASE; ++li) { a.ph_lo = li; a.ph_hi = li + 1; a.li = li; hipLaunchKernelGGL(mk_fwd, dim3(grid), dim3(NWAVES * 64), LDS_BYTES, stream, a); }
#else
    a.ph_lo = 0; a.ph_hi = NPHASE; a.li = 0;
    hipLaunchKernelGGL(mk_fwd, dim3(grid), dim3(NWAVES * 64), LDS_BYTES, stream, a);
#if defined(MK_DUP_ALL)
    (void)hipMemsetAsync((char*)d_ws + WS_CTL, 0, CTL_ZERO_BYTES, stream);
    hipLaunchKernelGGL(mk_fwd, dim3(grid), dim3(NWAVES * 64), LDS_BYTES, stream, a);
#endif
#endif
}
```

```cpp
#include <hip/hip_runtime.h>
#include <cstdio>
#include <cstdint>
namespace pg8 {
#define PG8_LAS __attribute__((address_space(3)))
typedef unsigned short bf16_t;
typedef short bf16x8 __attribute__((ext_vector_type(8)));
typedef float f32x4 __attribute__((ext_vector_type(4)));
typedef unsigned u32x4 __attribute__((ext_vector_type(4)));
constexpr int BM = 256, BK = 64, HALF = 128, HTB = HALF * BK * 2  , STAGE_BYTES = 8 * HTB, NXCD = 8, WGM = 8;

__host__ __device__ __forceinline__ int lds_byte(int r, int c) { const int st = (r >> 4) * 2 + (c >> 5), rr = r & 15, cc = c & 31, ob = rr * 64 + cc * 2; return st * 1024 + (ob ^ (((ob >> 9) & 1) << 5)); }
__host__ __device__ __forceinline__ void stage_rc(int b, int& R, int& C) { const int st = b / 1024, sb = b % 1024, swz = sb ^ (((sb >> 9) & 1) << 5); R = (st >> 1) * 16 + swz / 64; C = (st & 1) * 32 + (swz % 64) / 2; }
__host__ __device__ __forceinline__ unsigned stage_lin(int b) { const int st = b / 1024, sb = b % 1024; return (unsigned)(st * 1024 + (sb ^ (((sb >> 9) & 1) << 5))); }
__host__ __device__ __forceinline__ int perm32(int rho) { const int n = rho >> 4, i = rho & 15; return 8 * (i >> 2) + 4 * n + (i & 3); }

struct Unit { int pm, pn; };
struct Gemm { const bf16_t* A; const bf16_t* Bt; int M, N, K; };

struct StaticOrder {
    int nM, nN, nwg, G, c;
    __host__ __device__ void init(int M, int N, int G_, int c_) { nM = M / BM; nN = N / BM; nwg = nM * nN; G = G_; c = c_; }
    __host__ __device__ bool next(int i, Unit& u) const {
        const long L = (long)i * G + c; if (L >= nwg) return false;
        int wgid = (int)L; { const int q = nwg / NXCD, r = nwg % NXCD, xcd = wgid % NXCD, off = wgid / NXCD; wgid = (xcd < r ? xcd * (q + 1) : r * (q + 1) + (xcd - r) * q) + off; }
        const int nig = WGM * nN, gid = wgid / nig, fm = gid * WGM, gsz = (nM - fm) < WGM ? (nM - fm) : WGM;
        u.pm = fm + ((wgid % nig) % gsz); u.pn = (wgid % nig) / gsz; return true;
    }
    __device__ __forceinline__ void a_ready(const Unit&) const {}
    __device__ __forceinline__ void done(const Unit&) const {}
};

__device__ __forceinline__ unsigned cvt_pk_bf16(float lo, float hi) { unsigned r; asm volatile("v_cvt_pk_bf16_f32 %0, %1, %2" : "=v"(r) : "v"(lo), "v"(hi)); return r; }
typedef float f32x2 __attribute__((ext_vector_type(2)));
template <class Epi, class Sched, bool ALIGN_EPI = false, bool SP2 = false, bool ATILED = false, int AUXA = 0, int AUXB = 0>
__device__ __forceinline__ void gemm_phase(PG8_LAS unsigned char* lds, const Gemm g, const Sched& S, const Epi& E) {
    const int tid = threadIdx.x, wid = __builtin_amdgcn_readfirstlane(tid >> 6), lane = tid & 63, wr = wid >> 2, wc = wid & 3, fr = lane & 15, fq = lane >> 4;
    const int K = g.K, nt = K / BK;
    unsigned voffA[2], voffB[2];
#pragma unroll
    for (int i = 0; i < 2; ++i) { int R, C; stage_rc(tid * 16 + i * 8192, R, C); const int Rb = Epi::PERM ? ((R & ~31) + perm32(R & 31)) : R;
        voffA[i] = ATILED ? stage_lin(tid * 16 + i * 8192) : (unsigned)(R * K + C) * 2u; voffB[i] = ATILED ? stage_lin(tid * 16 + i * 8192) : (unsigned)(Rb * K + C) * 2u; }
    const size_t kstep = ATILED ? (size_t)32768 : (size_t)(BK * 2);
    const size_t hstep = ATILED ? (size_t)16384 : (size_t)HALF * K * 2;
    const size_t kstepA = ATILED ? (size_t)32768 : kstep, hstepA = ATILED ? (size_t)16384 : hstep;
    const size_t tstep = (size_t)2 * HALF * K * 2;
    const unsigned ldsw = (unsigned)wid * 1024u;
    const int aoff = lds_byte(wr * 64 + fr, fq * 8), boff = lds_byte(wc * 32 + fr, fq * 8);
#define PG8_SA(b, h) (((b) * 2 + (h)) * HTB)
#define PG8_SB(b, h) ((4 + (b) * 2 + (h)) * HTB)
#ifndef PG8_DMA_AUX_A
#define PG8_DMA_AUX_A 0
#endif
#ifndef PG8_DMA_AUX_B
#define PG8_DMA_AUX_B 0
#endif
#define PG8_STAGE_X(bufoff, gbase, voff, AUX) do { _Pragma("unroll") for (int _i = 0; _i < 2; ++_i) \
        __builtin_amdgcn_global_load_lds((const unsigned*)((const char*)(gbase) + (voff)[_i]), (PG8_LAS unsigned*)(lds + (bufoff) + ldsw + _i * 8192), 16, 0, AUX); } while (0)
#define PG8_LDA(dst, b, h) do { _Pragma("unroll") for (int m = 0; m < 4; ++m) _Pragma("unroll") for (int k = 0; k < 2; ++k) dst[m][k] = *(const PG8_LAS bf16x8*)(lds + PG8_SA(b, h) + aoff + m * 2048 + k * 1024); } while (0)
#define PG8_LDB(dst, b, h) do { _Pragma("unroll") for (int n = 0; n < 2; ++n) _Pragma("unroll") for (int k = 0; k < 2; ++k) dst[n][k] = *(const PG8_LAS bf16x8*)(lds + PG8_SB(b, h) + boff + n * 2048 + k * 1024); } while (0)
#define PG8_MMA(ai, bj, At, Bt) do { __builtin_amdgcn_s_setprio(1); _Pragma("unroll") for (int m = 0; m < 4; ++m) _Pragma("unroll") for (int n = 0; n < 2; ++n) _Pragma("unroll") for (int k = 0; k < 2; ++k) \
        acc[ai][bj][m][n] = __builtin_amdgcn_mfma_f32_16x16x32_bf16(Bt[n][k], At[m][k], acc[ai][bj][m][n], 0, 0, 0); __builtin_amdgcn_s_setprio(0); } while (0)
#define PG8_WAIT_V(n) asm volatile("s_waitcnt vmcnt(" #n ")" ::: "memory")
#define PG8_WAIT_L(n) asm volatile("s_waitcnt lgkmcnt(" #n ")" ::: "memory")
#define PG8_BAR __builtin_amdgcn_s_barrier()
#define PG8_SCHED __builtin_amdgcn_sched_barrier(0)
    Unit cur, nxt; int ui = 0;
    if (!S.next(0, cur)) return;
    f32x4 acc[2][2][4][2];
#pragma unroll
    for (int a = 0; a < 2; ++a)
#pragma unroll
        for (int b = 0; b < 2; ++b)
#pragma unroll
            for (int m = 0; m < 4; ++m)
#pragma unroll
                for (int n = 0; n < 2; ++n) acc[a][b][m][n] = (f32x4){0.f, 0.f, 0.f, 0.f};
    bf16x8 At[4][2], B0[2][2], B1[2][2];
    const char* cA = (const char*)g.A + (size_t)cur.pm * tstep; const char* cB = (const char*)g.Bt + (size_t)cur.pn * tstep;
    S.a_ready(cur);
    if constexpr (SP2) {
        PG8_STAGE_X(PG8_SB(0, 0), cB, voffB, AUXB); PG8_STAGE_X(PG8_SB(0, 1), cB + hstep, voffB, AUXB); PG8_STAGE_X(PG8_SA(0, 0), cA, voffA, AUXA); PG8_STAGE_X(PG8_SA(0, 1), cA + hstepA, voffA, AUXA);
        if (wr == 1) PG8_BAR;
        PG8_WAIT_V(2); PG8_BAR;
        PG8_STAGE_X(PG8_SB(1, 0), cB + kstep, voffB, AUXB); PG8_STAGE_X(PG8_SA(1, 0), cA + kstepA, voffA, AUXA); PG8_STAGE_X(PG8_SB(1, 1), cB + hstep + kstep, voffB, AUXB);
        PG8_WAIT_V(6); PG8_BAR;
    } else {
        PG8_STAGE_X(PG8_SB(0, 0), cB, voffB, AUXB); PG8_STAGE_X(PG8_SA(0, 0), cA, voffA, AUXA); PG8_STAGE_X(PG8_SB(0, 1), cB + hstep, voffB, AUXB); PG8_STAGE_X(PG8_SA(0, 1), cA + hstepA, voffA, AUXA);
        if (wr == 1) PG8_BAR;
        PG8_WAIT_V(4); PG8_BAR;
        PG8_STAGE_X(PG8_SB(1, 0), cB + kstep, voffB, AUXB); PG8_STAGE_X(PG8_SA(1, 0), cA + kstepA, voffA, AUXA); PG8_STAGE_X(PG8_SB(1, 1), cB + hstep + kstep, voffB, AUXB);
        PG8_WAIT_V(6); PG8_BAR;
    }
    for (;;) {
        const bool has_next = S.next(ui + 1, nxt);
        const char* nA = has_next ? (const char*)g.A + (size_t)nxt.pm * tstep : cA; const char* nB = has_next ? (const char*)g.Bt + (size_t)nxt.pn * tstep : cB;
        for (int t = 0; t < nt; t += 2) {
            const bool last = (t == nt - 2);
            const char* a1 = cA + (size_t)(t + 1) * kstepA;
            const char* a2 = last ? nA : cA + (size_t)(t + 2) * kstepA; const char* b2 = last ? nB : cB + (size_t)(t + 2) * kstep;
            const char* a3 = a2 + kstepA; const char* b3 = b2 + kstep;
            if (last && has_next) S.a_ready(nxt);
            if constexpr (SP2) {
            PG8_LDB(B0, 0, 0); PG8_LDB(B1, 0, 1); PG8_SCHED; PG8_LDA(At, 0, 0); PG8_STAGE_X(PG8_SA(1, 1), a1 + hstepA, voffA, AUXA);
            PG8_WAIT_V(8); PG8_WAIT_L(0); PG8_BAR; PG8_MMA(0, 0, At, B0); PG8_MMA(0, 1, At, B1); PG8_BAR; PG8_SCHED;
            PG8_LDA(At, 0, 1); PG8_STAGE_X(PG8_SB(0, 0), b2, voffB, AUXB); PG8_STAGE_X(PG8_SB(0, 1), b2 + hstep, voffB, AUXB); PG8_STAGE_X(PG8_SA(0, 0), a2, voffA, AUXA);
            PG8_WAIT_V(8); PG8_WAIT_L(0); PG8_BAR; PG8_MMA(1, 0, At, B0); PG8_MMA(1, 1, At, B1); PG8_BAR; PG8_SCHED;
            PG8_LDB(B0, 1, 0); PG8_LDB(B1, 1, 1); PG8_SCHED; PG8_LDA(At, 1, 0); PG8_STAGE_X(PG8_SA(0, 1), a2 + hstepA, voffA, AUXA);
            PG8_WAIT_V(8); PG8_WAIT_L(0); PG8_BAR; PG8_MMA(0, 0, At, B0); PG8_MMA(0, 1, At, B1); PG8_BAR; PG8_SCHED;
            PG8_LDA(At, 1, 1); PG8_STAGE_X(PG8_SB(1, 0), b3, voffB, AUXB); PG8_STAGE_X(PG8_SB(1, 1), b3 + hstep, voffB, AUXB); PG8_STAGE_X(PG8_SA(1, 0), a3, voffA, AUXA);
            PG8_WAIT_V(8); PG8_WAIT_L(0); PG8_BAR; PG8_MMA(1, 0, At, B0); PG8_MMA(1, 1, At, B1); PG8_BAR; PG8_SCHED;
            } else {
            PG8_LDB(B0, 0, 0); PG8_SCHED; PG8_LDA(At, 0, 0); PG8_STAGE_X(PG8_SA(1, 1), a1 + hstepA, voffA, AUXA);
            PG8_WAIT_L(8); PG8_BAR; PG8_WAIT_L(0); PG8_MMA(0, 0, At, B0); PG8_BAR; PG8_SCHED;
            PG8_LDB(B1, 0, 1); PG8_STAGE_X(PG8_SB(0, 0), b2, voffB, AUXB);
            PG8_BAR; PG8_WAIT_L(0); PG8_MMA(0, 1, At, B1); PG8_BAR;
            PG8_LDA(At, 0, 1); PG8_STAGE_X(PG8_SA(0, 0), a2, voffA, AUXA);
            PG8_BAR; PG8_WAIT_L(0); PG8_MMA(1, 0, At, B0); PG8_BAR; PG8_SCHED;
            PG8_STAGE_X(PG8_SB(0, 1), b2 + hstep, voffB, AUXB);
            PG8_WAIT_V(6); PG8_BAR; PG8_MMA(1, 1, At, B1); PG8_BAR;
            PG8_LDB(B0, 1, 0); PG8_SCHED; PG8_LDA(At, 1, 0); PG8_STAGE_X(PG8_SA(0, 1), a2 + hstepA, voffA, AUXA);
            PG8_WAIT_L(8); PG8_BAR; PG8_WAIT_L(0); PG8_MMA(0, 0, At, B0); PG8_BAR; PG8_SCHED;
            PG8_LDB(B1, 1, 1); PG8_STAGE_X(PG8_SB(1, 0), b3, voffB, AUXB);
            PG8_BAR; PG8_WAIT_L(0); PG8_MMA(0, 1, At, B1); PG8_BAR;
            PG8_LDA(At, 1, 1); PG8_STAGE_X(PG8_SA(1, 0), a3, voffA, AUXA);
            PG8_BAR; PG8_WAIT_L(0); PG8_MMA(1, 0, At, B0); PG8_BAR; PG8_SCHED;
            PG8_STAGE_X(PG8_SB(1, 1), b3 + hstep, voffB, AUXB);
            PG8_WAIT_V(6); PG8_BAR; PG8_MMA(1, 1, At, B1); PG8_BAR;
            }
        }
        if constexpr (ALIGN_EPI) { if (wr == 0) PG8_BAR; }
        if constexpr (!Epi::AFTER_DRAIN) { E(acc, cur, wr, wc, fr, fq); S.done(cur); }
        if (!has_next) break;
#pragma unroll
        for (int a = 0; a < 2; ++a)
#pragma unroll
            for (int b = 0; b < 2; ++b)
#pragma unroll
                for (int m = 0; m < 4; ++m)
#pragma unroll
                    for (int n = 0; n < 2; ++n) acc[a][b][m][n] = (f32x4){0.f, 0.f, 0.f, 0.f};
        cur = nxt; cA = nA; cB = nB; ++ui;
        if constexpr (ALIGN_EPI) { if (wr == 1) PG8_BAR; }
    }
    PG8_WAIT_V(0);
    if constexpr (!ALIGN_EPI) { if (wr == 0) PG8_BAR; }
    PG8_BAR;
    if constexpr (Epi::AFTER_DRAIN) { E.fused(acc, cur, wr, wc, fr, fq, lds, wid, lane); S.done(cur); }
#undef PG8_SA
#undef PG8_SB
#undef PG8_STAGE_X
#undef PG8_LDA
#undef PG8_LDB
#undef PG8_MMA
#undef PG8_WAIT_V
#undef PG8_WAIT_L
#undef PG8_BAR
#undef PG8_SCHED
}
}
namespace pg8 {
constexpr float NORM_EPS_F = 1e-6f;
constexpr float C2 = 0.125f * 1.4426950408889634f;
__device__ __forceinline__ size_t tiled_off(int row, int col, int KT) { return ((((size_t)(row >> 8) * KT + (col >> 6)) * 32 + ((row & 255) >> 4) * 2 + ((col & 63) >> 5)) * 512) + (row & 15) * 32 + (col & 31); }
__host__ __device__ __forceinline__ int perm32inv(int x) { return 16 * ((x >> 2) & 1) + 4 * (x >> 3) + (x & 3); }
__device__ __forceinline__ float row4_sum(float s) {
    unsigned a = __builtin_bit_cast(unsigned, s), b = a; asm volatile("" : "+v"(b));
    auto r = __builtin_amdgcn_permlane16_swap(a, b, false, false);
    unsigned r0 = r[0], r1 = r[1]; asm volatile("" : "+v"(r0), "+v"(r1));
    s = __builtin_bit_cast(float, r0) + __builtin_bit_cast(float, r1);
    a = __builtin_bit_cast(unsigned, s); b = a; asm volatile("" : "+v"(b));
    auto q = __builtin_amdgcn_permlane32_swap(a, b, false, false);
    unsigned q0 = q[0], q1 = q[1]; asm volatile("" : "+v"(q0), "+v"(q1));
    return __builtin_bit_cast(float, q0) + __builtin_bit_cast(float, q1);
}
__device__ __forceinline__ float hsum4(const f32x4 v) { return (v[0] + v[1]) + (v[2] + v[3]); }
__device__ __forceinline__ float hsq4(const f32x4 v) { return (v[0] * v[0] + v[1] * v[1]) + (v[2] * v[2] + v[3] * v[3]); }
__device__ __forceinline__ u32x4 pack8(const f32x4 a, const f32x4 b) { u32x4 w; w.x = cvt_pk_bf16(a[0], a[1]); w.y = cvt_pk_bf16(a[2], a[3]); w.z = cvt_pk_bf16(b[0], b[1]); w.w = cvt_pk_bf16(b[2], b[3]); return w; }

struct EpiInProj {
    static constexpr bool PERM = true, AFTER_DRAIN = false;
    bf16_t *U, *Q, *K, *V; const float *qg, *kg;
    __device__ __forceinline__ void operator()(const f32x4 (&acc)[2][2][4][2], const Unit& u, int wr, int wc, int fr, int fq) const {
        const int row0 = u.pm * BM + wr * 64 + fr;
        const int kind = u.pn >> 1;
        if (kind == 0) {
            const int col0 = (u.pn & 1) * 256 + 64 * wc + 8 * fq;
#pragma unroll
            for (int ai = 0; ai < 2; ++ai)
#pragma unroll
                for (int m = 0; m < 4; ++m) { bf16_t* rowp = U + (size_t)(row0 + ai * HALF + m * 16) * 512 + col0;
#pragma unroll
                    for (int bj = 0; bj < 2; ++bj) *(u32x4*)(rowp + 32 * bj) = pack8(acc[ai][bj][m][0], acc[ai][bj][m][1]); }
        } else {
            const int head = 4 * (u.pn & 1) + wc;
            bf16_t* dst = kind == 1 ? Q : (kind == 2 ? K : V);
            const float* g = kind == 1 ? qg : kg;
            const float gs = kind == 1 ? C2 : 1.0f;
            f32x4 gv[2][2];
#pragma unroll
            for (int bj = 0; bj < 2; ++bj)
#pragma unroll
                for (int n = 0; n < 2; ++n) gv[bj][n] = (kind == 3) ? (f32x4){1.f, 1.f, 1.f, 1.f} : *(const f32x4*)(g + 32 * bj + 8 * fq + 4 * n) * gs;
#pragma unroll
            for (int ai = 0; ai < 2; ++ai)
#pragma unroll
                for (int m = 0; m < 4; ++m) {
                    const int row = row0 + ai * HALF + m * 16, b = row >> 13, t = row & 8191;
                    bf16_t* rowp = dst + ((size_t)(b * 8 + head) * 8192 + t) * 64 + 8 * fq;
                    float ss = (hsq4(acc[ai][0][m][0]) + hsq4(acc[ai][0][m][1])) + (hsq4(acc[ai][1][m][0]) + hsq4(acc[ai][1][m][1]));
                    ss = row4_sum(ss);
                    const float r = (kind == 3) ? 1.0f : __builtin_amdgcn_rsqf(ss * (1.0f / 64.0f) + NORM_EPS_F);
#pragma unroll
                    for (int bj = 0; bj < 2; ++bj) *(u32x4*)(rowp + 32 * bj) = pack8(acc[ai][bj][m][0] * gv[bj][0] * r, acc[ai][bj][m][1] * gv[bj][1] * r);
                }
        }
    }
};
struct EpiOut {
    static constexpr bool PERM = true, AFTER_DRAIN = false;
    const bf16_t* XN; const float* RN1; bf16_t* HB; float* RSS;
    __device__ __forceinline__ void operator()(const f32x4 (&acc)[2][2][4][2], const Unit& u, int wr, int wc, int fr, int fq) const {
        const int row0 = u.pm * BM + wr * 64 + fr, col0 = u.pn * BM + wc * 32 + 8 * fq;
#pragma unroll
        for (int ai = 0; ai < 2; ++ai) {
            u32x4 xv[4][2]; float rn[4];
#pragma unroll
            for (int m = 0; m < 4; ++m) { const int row = row0 + ai * HALF + m * 16; rn[m] = RN1[row];
#pragma unroll
                for (int bj = 0; bj < 2; ++bj) xv[m][bj] = __builtin_nontemporal_load((const u32x4*)(XN + tiled_off(row, col0 + bj * HALF, 16))); }
#pragma unroll
            for (int m = 0; m < 4; ++m) {
                const int row = row0 + ai * HALF + m * 16; float ss = 0.f; const float rnv = rn[m];
#pragma unroll
                for (int bj = 0; bj < 2; ++bj) {
                    const u32x4 v = xv[m][bj];
                    f32x4 x0, x1;
                    x0[0] = __builtin_bit_cast(float, v.x << 16); x0[1] = __builtin_bit_cast(float, v.x & 0xffff0000u); x0[2] = __builtin_bit_cast(float, v.y << 16); x0[3] = __builtin_bit_cast(float, v.y & 0xffff0000u);
                    x1[0] = __builtin_bit_cast(float, v.z << 16); x1[1] = __builtin_bit_cast(float, v.z & 0xffff0000u); x1[2] = __builtin_bit_cast(float, v.w << 16); x1[3] = __builtin_bit_cast(float, v.w & 0xffff0000u);
                    const f32x4 h0 = x0 * rnv + acc[ai][bj][m][0], h1 = x1 * rnv + acc[ai][bj][m][1];
                    ss += hsq4(h0) + hsq4(h1);
                    *(u32x4*)(HB + tiled_off(row, col0 + bj * HALF, 16)) = pack8(h0, h1);
                }
                ss = row4_sum(ss);
                if (fq == 0) RSS[(size_t)row * 16 + u.pn * 4 + wc] = ss;
            }
        }
    }
};
struct EpiUp {
    static constexpr bool PERM = true, AFTER_DRAIN = false;
    bf16_t* FF;
    __device__ __forceinline__ void operator()(const f32x4 (&acc)[2][2][4][2], const Unit& u, int wr, int wc, int fr, int fq) const {
        const int row0 = u.pm * BM + wr * 64 + fr, col0 = u.pn * BM + wc * 32 + 8 * fq;
#pragma unroll
        for (int ai = 0; ai < 2; ++ai)
#pragma unroll
            for (int m = 0; m < 4; ++m) {
                const int row = row0 + ai * HALF + m * 16;
#pragma unroll
                for (int bj = 0; bj < 2; ++bj) {
                    f32x4 v0 = acc[ai][bj][m][0], v1 = acc[ai][bj][m][1];
#pragma unroll
                    for (int e = 0; e < 4; ++e) { v0[e] = __builtin_fmaxf(v0[e], 0.f); v1[e] = __builtin_fmaxf(v1[e], 0.f); }
                    __builtin_nontemporal_store(pack8(v0 * v0, v1 * v1), (u32x4*)(FF + tiled_off(row, col0 + bj * HALF, 64)));
                }
            }
    }
};
struct EpiDown {
    static constexpr bool PERM = true, AFTER_DRAIN = false;
    const bf16_t* HB; const float* RSS; float* out;
    __device__ __forceinline__ void operator()(const f32x4 (&acc)[2][2][4][2], const Unit& u, int wr, int wc, int fr, int fq) const {
        const int row0 = u.pm * BM + wr * 64 + fr, col0 = u.pn * BM + wc * 32 + 8 * fq;
#pragma unroll
        for (int ai = 0; ai < 2; ++ai) {
            u32x4 hv[4][2]; f32x4 rsv[4];
#pragma unroll
            for (int m = 0; m < 4; ++m) { rsv[m] = *(const f32x4*)(RSS + (size_t)(row0 + ai * HALF + m * 16) * 16 + 4 * fq);
#pragma unroll
                for (int bj = 0; bj < 2; ++bj) hv[m][bj] = __builtin_nontemporal_load((const u32x4*)(HB + tiled_off(row0 + ai * HALF + m * 16, col0 + bj * HALF, 16))); }
#pragma unroll
            for (int m = 0; m < 4; ++m) { const int row = row0 + ai * HALF + m * 16; const size_t off = (size_t)row * 1024 + col0;
                const float s2 = 1.0f / (row4_sum(hsum4(rsv[m])) * (1.0f / 1024.0f) + NORM_EPS_F);
#pragma unroll
                for (int bj = 0; bj < 2; ++bj) { const u32x4 v = hv[m][bj];
                    f32x4 h0, h1;
                    h0[0] = __builtin_bit_cast(float, v.x << 16); h0[1] = __builtin_bit_cast(float, v.x & 0xffff0000u); h0[2] = __builtin_bit_cast(float, v.y << 16); h0[3] = __builtin_bit_cast(float, v.y & 0xffff0000u);
                    h1[0] = __builtin_bit_cast(float, v.z << 16); h1[1] = __builtin_bit_cast(float, v.z & 0xffff0000u); h1[2] = __builtin_bit_cast(float, v.w << 16); h1[3] = __builtin_bit_cast(float, v.w & 0xffff0000u);
                    *(f32x4*)(out + off + bj * HALF) = h0 + acc[ai][bj][m][0] * s2; *(f32x4*)(out + off + bj * HALF + 4) = h1 + acc[ai][bj][m][1] * s2; } }
        }
    }
};
}
#include <cmath>
#define GAS __attribute__((address_space(1)))
#define LAS __attribute__((address_space(3)))
typedef unsigned short bf16;
typedef unsigned v4u __attribute__((ext_vector_type(4)));
typedef float f32x4 __attribute__((ext_vector_type(4)));
typedef short bf16x8 __attribute__((ext_vector_type(8)));
typedef GAS unsigned gu32;
typedef GAS unsigned long long gu64;
#define RLX_AGENT __ATOMIC_RELAXED, __HIP_MEMORY_SCOPE_AGENT
#define LDS_WAIT() asm volatile("s_waitcnt lgkmcnt(0)" ::: "memory")
#define VM_WAIT() asm volatile("s_waitcnt vmcnt(0)" ::: "memory")
__device__ __forceinline__ unsigned long long rt() { return __builtin_amdgcn_s_memrealtime(); }
__device__ __forceinline__ unsigned f2bf(float f) { unsigned u = __builtin_bit_cast(unsigned, f); return (u + 0x7fffu + ((u >> 16) & 1u)) >> 16; }
__device__ __forceinline__ unsigned pk2(float lo, float hi) { return f2bf(lo) | (f2bf(hi) << 16); }

#define XB_TMO      128
#define XB_XCNT(j)  (256  + 64 * (j))
#define XB_XSUB(j)  (1280 + 64 * (j))
#define XB_XGEN(j)  (2304 + 64 * (j))
#define XB_TOP      3328
#define XB_TOPGEN   3392
#define XCD_BAR_WORDS 3456
#define XB_SPIN_CAP (1u << 18)

__device__ __forceinline__ unsigned xb_ld(unsigned* p)              { return __hip_atomic_load(p, __ATOMIC_RELAXED, __HIP_MEMORY_SCOPE_AGENT); }
__device__ __forceinline__ unsigned xb_add(unsigned* p, unsigned v) { return __hip_atomic_fetch_add(p, v, __ATOMIC_RELAXED, __HIP_MEMORY_SCOPE_AGENT); }
__device__ __forceinline__ unsigned xb_xcc_id() { return (unsigned)__builtin_amdgcn_s_getreg((3 << 11) | 20) & 0xFu; }
#define XB_SPIN(cond, bar) do { unsigned _sp = 0; while (cond) { __builtin_amdgcn_s_sleep(1); \
    if ((++_sp & 255u) == 0u) { if (xb_ld(&(bar)[XB_TMO])) break; if (_sp > XB_SPIN_CAP) { atomicAdd(&(bar)[XB_TMO], 1u); break; } } } } while (0)

struct XcdBarrier {
    unsigned* bar; unsigned x;
    volatile LAS unsigned* st;
};

__device__ __forceinline__ XcdBarrier xcd_barrier_post(unsigned* bar, volatile LAS unsigned* st) {
    XcdBarrier b; b.bar = bar; b.x = xb_xcc_id(); b.st = st;
    if (threadIdx.x == 0) (void)xb_add(&bar[XB_XCNT(b.x)], 1u);
    return b;
}
__device__ __forceinline__ void xcd_barrier_complete(unsigned* bar, unsigned x, unsigned& nloc, unsigned& nx) {
    const unsigned G = gridDim.x * gridDim.y * gridDim.z;
    unsigned sum, cnt, mine, sp = 0u;
    for (;;) {
        sum = 0u; cnt = 0u; mine = 0u;
#pragma unroll
        for (unsigned j = 0; j < 16; ++j) { const unsigned c = xb_ld(&bar[XB_XCNT(j)]); sum += c; cnt += (c > 0u) ? 1u : 0u; mine = (j == x) ? c : mine; }
        if (sum == G) break;
        __builtin_amdgcn_s_sleep(1);
        if ((++sp & 255u) == 0u) { if (xb_ld(&bar[XB_TMO])) break; if (sp > XB_SPIN_CAP) { atomicAdd(&bar[XB_TMO], 1u); break; } }
    }
    nloc = mine > 0u ? mine : 1u; nx = cnt > 0u ? cnt : 1u;
}

__device__ __forceinline__ void xcd_barrier(const XcdBarrier& b) {
    asm volatile("s_waitcnt vmcnt(0)" ::: "memory");
    __syncthreads();
    if (threadIdx.x == 0) {
        unsigned* bar = b.bar;
        __builtin_amdgcn_s_waitcnt(0);
        unsigned nloc = b.st[0], nx = b.st[1];
        if (nloc == 0u) { xcd_barrier_complete(bar, b.x, nloc, nx); b.st[0] = nloc; b.st[1] = nx; }
        const unsigned old = xb_add(&bar[XB_XSUB(b.x)], 1u);
        const unsigned gen = old / nloc;
        if (old + 1u == (gen + 1u) * nloc) {
            __builtin_amdgcn_fence(__ATOMIC_RELEASE, "agent");
            asm volatile("s_waitcnt vmcnt(0)" ::: "memory");
            const unsigned og = xb_add(&bar[XB_TOP], 1u);
            const unsigned tg = og / nx;
            if (og + 1u == (tg + 1u) * nx) xb_add(&bar[XB_TOPGEN], 1u);
            else XB_SPIN(xb_ld(&bar[XB_TOPGEN]) == tg, bar);
            __builtin_amdgcn_fence(__ATOMIC_ACQUIRE, "agent");
            xb_add(&bar[XB_XGEN(b.x)], 1u);
            asm volatile("s_waitcnt vmcnt(0)" ::: "memory");
        } else {
            XB_SPIN(xb_ld(&bar[XB_XGEN(b.x)]) == gen, bar);
            __builtin_amdgcn_fence(__ATOMIC_ACQUIRE, "agent");
            asm volatile("s_waitcnt vmcnt(0)" ::: "memory");
        }
    }
    __syncthreads();
}
constexpr int NWAVES = 8;
#ifndef MK_PER_PHASE
#define MK_PER_PHASE 0
#endif
constexpr int NPHASE = 9;

constexpr int BATCH = 4, T = 8192, D = 1024, NH = 8, HD = 64, FF = 4096, PW = 512, AW = 512;
constexpr int M = BATCH * T;
constexpr int NIN = PW + 3 * AW;
constexpr float NORM_EPS = 1e-6f;
constexpr float LOG2E = 1.4426950408889634f;

constexpr size_t MiB = 1u << 20;
constexpr size_t WS_CTL = 0, CTL_ZERO_BYTES = 1 * MiB;
constexpr size_t WS_WIN = 1 * MiB, WS_WOUT = 5 * MiB, WS_WUP = 7 * MiB, WS_WDN = 15 * MiB;
constexpr size_t WS_RSS = 23 * MiB;
constexpr size_t WS_PL = 25 * MiB;
constexpr size_t WS_RN1 = 27 * MiB;
constexpr size_t WS_HB = 28 * MiB;
constexpr size_t WS_FF = 92 * MiB;
constexpr size_t WS_XN = 92 * MiB, WS_U = 156 * MiB, WS_Q = 188 * MiB, WS_K = 220 * MiB, WS_V = 252 * MiB, WS_PO = 284 * MiB;
constexpr size_t WS_MIX = 348 * MiB;
constexpr size_t WS_END = 412 * MiB;
static_assert(WS_PO + 64 * MiB <= WS_FF + 256 * MiB && WS_MIX >= WS_FF + 256 * MiB && WS_HB + 64 * MiB <= WS_FF, "d_ws map");
constexpr int CW_BAR = 4096;

constexpr int RING_OFF = 0, RING_BYTES = 131072;
constexpr int LDSCTL_OFF = RING_BYTES, MISC_OFF = LDSCTL_OFF + 320;
constexpr int LDS_BYTES = 147456;

struct Frame {
    LAS unsigned char* lds;
    volatile LAS unsigned* MISC;
    gu32* ctl;
    int tid, lane, wave, vcu, G;
    const float *x, *g1, *w_in, *pool_w, *pool_s, *qg, *kg, *rel_bias, *w_out, *g2, *w_up, *w_dn;
    float* out;
    bf16 *Win_t, *Wout_t, *Wup_t, *Wdn_t;
    bf16 *XN, *U, *Q, *K, *V, *PO, *MIX, *HB, *FFB;
    float *RSS, *PL, *RN1;
};

__device__ __forceinline__ float wave_sum(float v) {
#pragma unroll
    for (int o = 1; o < 64; o <<= 1) v += __shfl_xor(v, o);
    return v;
}
__device__ __forceinline__ float wave_max(float v) {
#pragma unroll
    for (int o = 1; o < 64; o <<= 1) v = __builtin_fmaxf(v, __shfl_xor(v, o));
    return v;
}
__device__ __forceinline__ float bf2f(unsigned short h) { return __builtin_bit_cast(float, (unsigned)h << 16); }
__device__ __forceinline__ float bflo(unsigned w) { return __builtin_bit_cast(float, w << 16); }
__device__ __forceinline__ float bfhi(unsigned w) { return __builtin_bit_cast(float, w & 0xffff0000u); }

__device__ __forceinline__ void p0_transpose_item(const float* W, int N, bf16* WT, int KT, int kt_off, const float* gk, bool permute, LAS float* scr, int item, int lane) {
    const int nblk = N / 32, kb = item / nblk, nb = item % nblk, k0 = 64 * kb, n0 = 32 * nb;
    float tv[32];
#pragma unroll
    for (int i = 0; i < 32; ++i) tv[i] = __builtin_nontemporal_load(W + (size_t)(k0 + 2 * i + (lane >> 5)) * N + n0 + (lane & 31));
    if (gk) {
#pragma unroll
        for (int i = 0; i < 32; ++i) tv[i] *= gk[k0 + 2 * i + (lane >> 5)];
    }
#pragma unroll
    for (int i = 0; i < 32; ++i) scr[(2 * i + (lane >> 5)) * 33 + (lane & 31)] = tv[i];
    LDS_WAIT(); asm volatile("" ::: "memory");
    int rb = n0;
    if (permute) { const int pn = nb >> 3, w = nb & 7; rb = 256 * pn + 128 * (w & 1) + 32 * (w >> 1); }
    const int c = lane & 7;
#pragma unroll
    for (int j = 0; j < 4; ++j) { const int n = (lane >> 3) + 8 * j; const LAS float* s = scr + (8 * c) * 33 + n;
        v4u o; o.x = pk2(s[0 * 33], s[1 * 33]); o.y = pk2(s[2 * 33], s[3 * 33]); o.z = pk2(s[4 * 33], s[5 * 33]); o.w = pk2(s[6 * 33], s[7 * 33]);
        const int R = rb + pg8::perm32inv(n);
        *(GAS v4u*)(WT + pg8::tiled_off(R, 64 * (kt_off + kb) + 8 * c, KT)) = o; }
    LDS_WAIT(); asm volatile("" ::: "memory");
}
__device__ __forceinline__ void p0_fold_item(const Frame& F, int item, int lane) {
    const int g = item >> 9, r = item & 511, c0 = 8 * (r >> 5) + 4 * (lane >> 5), n = 32 * (r & 31) + (lane & 31);
    const float* pw = F.pool_w + ((size_t)g * 128 + c0) * 128; const float* ps = F.pool_s + 128 * g; const float* wo = F.w_out + (size_t)(128 * g) * D + n;
    float a0 = 0.f, a1 = 0.f, a2 = 0.f, a3 = 0.f;
#pragma unroll 8
    for (int d = 0; d < 128; d += 4) {
        const f32x4 p0 = *(const f32x4*)(pw + d), p1 = *(const f32x4*)(pw + 128 + d), p2 = *(const f32x4*)(pw + 256 + d), p3 = *(const f32x4*)(pw + 384 + d), s4 = *(const f32x4*)(ps + d);
#pragma unroll
        for (int e = 0; e < 4; ++e) { const float w = s4[e] * wo[(size_t)(d + e) * D]; a0 += p0[e] * w; a1 += p1[e] * w; a2 += p2[e] * w; a3 += p3[e] * w; }
    }
    *(GAS unsigned long long*)(F.Wout_t + pg8::tiled_off((n & ~31) + pg8::perm32inv(n & 31), 128 * g + c0, 16)) = (unsigned long long)pk2(a0, a1) | ((unsigned long long)pk2(a2, a3) << 32);
}
__device__ __forceinline__ void p0_prologue(Frame& F) {
    LAS float* scr = (LAS float*)(F.lds + RING_OFF + F.wave * 16384);
    const int gw = F.vcu * NWAVES + F.wave, NGW = F.G * NWAVES;
    constexpr int I_IN = (D / 64) * (NIN / 32), I_OUT = (512 / 64) * (D / 32), I_UP = (D / 64) * (FF / 32), I_DN = (FF / 64) * (D / 32), I_FOLD = 4 * 16 * 32;
    constexpr int NITEMS = I_IN + I_OUT + I_UP + I_DN + I_FOLD;
    for (int it = gw; it < NITEMS; it += NGW) {
        int r = it;
        if (r < I_FOLD) { p0_fold_item(F, r, F.lane); continue; } r -= I_FOLD;
        const float* W; const float* gk; bf16* WT; int N, KT, kt_off; bool perm;
        if (r < I_IN) { W = F.w_in; N = NIN; WT = F.Win_t; KT = 16; kt_off = 0; gk = F.g1; perm = true; }
        else if ((r -= I_IN) < I_OUT) { W = F.w_out + (size_t)512 * D; N = D; WT = F.Wout_t; KT = 16; kt_off = 8; gk = nullptr; perm = false; }
        else if ((r -= I_OUT) < I_UP) { W = F.w_up; N = FF; WT = F.Wup_t; KT = 16; kt_off = 0; gk = F.g2; perm = false; }
        else { r -= I_UP; W = F.w_dn; N = D; WT = F.Wdn_t; KT = 64; kt_off = 0; gk = nullptr; perm = false; }
        p0_transpose_item(W, N, WT, KT, kt_off, gk, perm, scr, r, F.lane);
    }
    {
        const int rsel = F.lane >> 4, j8 = 8 * (F.lane & 15);
        for (int m0 = 8 * gw; m0 < M; m0 += 8 * NGW) {
            f32x4 v[2][16];
#pragma unroll
            for (int q = 0; q < 2; ++q) { const GAS f32x4* xr = (const GAS f32x4*)(F.x + (size_t)(m0 + 4 * q + rsel) * D + j8);
#pragma unroll
                for (int i = 0; i < 8; ++i) { v[q][2 * i] = __builtin_nontemporal_load(xr + 32 * i); v[q][2 * i + 1] = __builtin_nontemporal_load(xr + 32 * i + 1); } }
#pragma unroll
            for (int q = 0; q < 2; ++q) { float s = 0.f; const int row = m0 + 4 * q + rsel;
#pragma unroll
                for (int i = 0; i < 16; ++i) s += (v[q][i].x * v[q][i].x + v[q][i].y * v[q][i].y) + (v[q][i].z * v[q][i].z + v[q][i].w * v[q][i].w);
                s += __builtin_bit_cast(float, __builtin_amdgcn_update_dpp(0, __builtin_bit_cast(int, s), 0xB1, 0xF, 0xF, false));
                s += __builtin_bit_cast(float, __builtin_amdgcn_update_dpp(0, __builtin_bit_cast(int, s), 0x4E, 0xF, 0xF, false));
                s += __builtin_bit_cast(float, __builtin_amdgcn_update_dpp(0, __builtin_bit_cast(int, s), 0x124, 0xF, 0xF, false));
                s += __builtin_bit_cast(float, __builtin_amdgcn_update_dpp(0, __builtin_bit_cast(int, s), 0x128, 0xF, 0xF, false));
                const float ms = s * (1.f / D) + NORM_EPS, rstd = __builtin_amdgcn_rsqf(ms);
                if ((F.lane & 15) == 0) F.RN1[row] = __builtin_sqrtf(ms);
#pragma unroll
                for (int i = 0; i < 8; ++i) { const f32x4 a = v[q][2 * i] * rstd, b = v[q][2 * i + 1] * rstd; v4u o; o.x = pk2(a.x, a.y); o.y = pk2(a.z, a.w); o.z = pk2(b.x, b.y); o.w = pk2(b.z, b.w);
                    *(GAS v4u*)(F.XN + pg8::tiled_off(row, j8 + 128 * i, 16)) = o; } }
        }
    }
}

__device__ __forceinline__ int t5_bucket_dev(int dist) {
    if (dist < 16) return dist;
    int l = 16 + (int)(__builtin_log2f((float)dist * (1.0f / 16.0f)) * (16.0f / 7.0f));
    return l < 31 ? l : 31;
}
#ifndef MK_KDMA_AUX
#define MK_KDMA_AUX 2
#endif
#ifndef MK_VDMA_AUX
#define MK_VDMA_AUX 2
#endif
namespace mixer {
typedef float f32x16 __attribute__((ext_vector_type(16)));
typedef short s16x4 __attribute__((ext_vector_type(4)));
typedef short v4i16_t __attribute__((ext_vector_type(4)));
constexpr int K_OFF = 0, V_OFF = 49152, OST_OFF = 98304, TBL_OFF = 131584, TBL_STRIDE = 192, WSF_OFF = TBL_OFF + 4 * TBL_STRIDE * 4, RB_OFF = WSF_OFF + 8 * 256, NEG_OFF = RB_OFF + 1024;
static_assert(NEG_OFF + 256 <= LDS_BYTES && TBL_OFF >= MISC_OFF + 128, "mixer LDS map");
constexpr float NEG_BIG = -1.0e30f;

__device__ __forceinline__ unsigned cvtpk(float lo, float hi) { typedef float f2 __attribute__((ext_vector_type(2))); typedef __bf16 b2 __attribute__((ext_vector_type(2))); f2 v = {lo, hi}; b2 b = __builtin_convertvector(v, b2); return __builtin_bit_cast(unsigned, b); }
__device__ __forceinline__ s16x4 vtr(const LAS unsigned char* p) { return __builtin_bit_cast(s16x4, __builtin_amdgcn_ds_read_tr16_b64_v4i16((LAS v4i16_t*)p)); }
__device__ __forceinline__ int crow(int r, int hi) { return (r & 3) + 8 * (r >> 2) + 4 * hi; }

__device__ __forceinline__ float softmax_ref(const Frame& F) {
    float mq = __builtin_fabsf(F.qg[F.lane]), mk = __builtin_fabsf(F.kg[F.lane]);
    const f32x4 bv = *(const f32x4*)(F.rel_bias + 4 * F.lane);
    float mb = __builtin_fmaxf(__builtin_fmaxf(__builtin_fabsf(bv[0]), __builtin_fabsf(bv[1])), __builtin_fmaxf(__builtin_fabsf(bv[2]), __builtin_fabsf(bv[3])));
    mq = wave_max(mq); mk = wave_max(mk); mb = wave_max(mb);
    return (pg8::C2 * 64.0f * mq * mk + mb * LOG2E) * 1.02f + 0.25f;
}

struct ItemP { int b, h, d, r, c, ps, base; };
template <bool FINAL> __device__ __forceinline__ bool item_decode(const Frame& F, int i, ItemP& p) {
    int bh;
    if (!FINAL) {
        if (F.G == 256) {
            if (i >= 8) return false;
            const int xg = F.vcu >> 5, cu = F.vcu & 31;
            if (i < 4) { bh = 4 * xg + (cu >> 3); p.d = 4; p.r = (cu >> 1) & 3; p.c = 4 * (cu & 1) + i; p.ps = 0; p.base = 4 * i; }
            else { const int rho = 2 * cu + ((i - 4) >> 1); bh = 4 * xg + (rho >> 4); p.d = 16; p.r = rho & 15; p.c = (i - 4) & 1; p.ps = 1; p.base = 4 * ((i - 4) & 1); }
        } else {
            const int L = (int)blockIdx.x + i * F.G; if (L >= 2048) return false; bh = L >> 6; const int sub = L & 63, s = sub & 31; p.base = 0;
            if ((sub >> 5) == 0) { p.d = 4; p.r = s >> 3; p.c = s & 7; p.ps = 0; } else { p.d = 16; p.r = s >> 1; p.c = s & 1; p.ps = 1; }
        }
    } else {
        if (F.G == 256) { if (i >= 4) return false; const int cu = F.vcu & 31; bh = 4 * (F.vcu >> 5) + (cu >> 3); p.c = 4 * (cu & 7) + i; p.base = 4 * i; }
        else { const int L = (int)blockIdx.x + i * F.G; if (L >= 1024) return false; bh = L >> 5; p.c = L & 31; p.base = 0; }
        p.d = 1; p.r = 0; p.ps = 0;
    }
    p.b = bh >> 3; p.h = bh & 7; return true;
}
__device__ __forceinline__ void issue_k(const Frame& F, const ItemP& p) {
    const int lane = F.lane, w = F.wave, kpos0 = 256 * p.c - 128;
    const bf16* Kh = F.K + (size_t)(p.b * 8 + p.h) * 8192 * 64;
    const int cs = ((lane & 7) ^ (lane >> 3)) * 8;
#pragma unroll
    for (int i = 0; i < 6; ++i) { if (i < 2 && p.base != 0) continue;
        int pos = kpos0 + i * 64 + 8 * w + (lane >> 3); pos = pos < 0 ? 0 : pos;
        const int slot = (p.base + i) % 6;
        __builtin_amdgcn_global_load_lds((const unsigned*)(Kh + (size_t)(p.r + p.d * pos) * 64 + cs), (LAS unsigned*)(F.lds + K_OFF + slot * 8192 + w * 1024), 16, 0, MK_KDMA_AUX); }
}
__device__ __forceinline__ void issue_v(const Frame& F, const ItemP& p) {
    const int lane = F.lane, w = F.wave, kpos0 = 256 * p.c - 128;
    const bf16* Vh = F.V + (size_t)(p.b * 8 + p.h) * 8192 * 64;
    const int cs = ((lane & 7) ^ (((lane >> 4) & 1) << 2)) * 8;
#pragma unroll
    for (int i = 0; i < 6; ++i) { if (i < 2 && p.base != 0) continue;
        int pos = kpos0 + i * 64 + 8 * w + (lane >> 3); pos = pos < 0 ? 0 : pos;
        const int slot = (p.base + i) % 6;
        __builtin_amdgcn_global_load_lds((const unsigned*)(Vh + (size_t)(p.r + p.d * pos) * 64 + cs), (LAS unsigned*)(F.lds + V_OFF + slot * 8192 + w * 1024), 16, 0, MK_VDMA_AUX); }
}
__device__ __forceinline__ void build_table(const Frame& F, const ItemP& p, float MB2) {
    LAS float* tbl = (LAS float*)(F.lds + TBL_OFF); const LAS float* rb = (const LAS float*)(F.lds + RB_OFF);
    for (int idx = F.tid; idx < 4 * TBL_STRIDE; idx += NWAVES * 64) {
        const int m = idx / TBL_STRIDE, i = idx - m * TBL_STRIDE, dist = 160 - (i + ((4 - m) & 3));
        float v = NEG_BIG;
        if (dist >= 0 && dist <= 128) v = rb[t5_bucket_dev(dist * p.d) * NH + p.h] * LOG2E - MB2;
        tbl[idx] = v;
    }
}
__device__ __forceinline__ void load_q(const Frame& F, const ItemP& p, bf16x8 (&q)[4]) {
    const int r32 = F.lane & 31, hi = F.lane >> 5, qpos = 256 * p.c + 32 * F.wave + r32;
    const bf16* qrow = F.Q + ((size_t)(p.b * 8 + p.h) * 8192 + (size_t)(p.r + p.d * qpos)) * 64 + hi * 8;
    v4u t0, t1, t2, t3;
    asm volatile("global_load_dwordx4 %0, %4, off\n\tglobal_load_dwordx4 %1, %4, off offset:32\n\tglobal_load_dwordx4 %2, %4, off offset:64\n\tglobal_load_dwordx4 %3, %4, off offset:96"
                 : "=&v"(t0), "=&v"(t1), "=&v"(t2), "=&v"(t3) : "v"(qrow) : "memory");
    q[0] = __builtin_bit_cast(bf16x8, t0); q[1] = __builtin_bit_cast(bf16x8, t1); q[2] = __builtin_bit_cast(bf16x8, t2); q[3] = __builtin_bit_cast(bf16x8, t3);
}

template <bool FINAL>
__device__ __forceinline__ void attn_phase(Frame& F, float MB2) {
    const int lane = F.lane, w = F.wave, r32 = lane & 31, hi = lane >> 5;
    LAS unsigned char* lds = F.lds;
    if (F.tid < 256) ((LAS float*)(lds + RB_OFF))[F.tid] = F.rel_bias[F.tid];
    if (F.tid < 64) ((LAS float*)(lds + NEG_OFF))[F.tid] = NEG_BIG;
    ItemP cur, nxt; nxt.b = nxt.h = nxt.d = nxt.r = nxt.c = nxt.ps = nxt.base = 0;
    bool has = item_decode<FINAL>(F, 0, cur);
    bf16x8 qr[4];
#pragma unroll
    for (int d0 = 0; d0 < 4; ++d0) qr[d0] = (bf16x8){0, 0, 0, 0, 0, 0, 0, 0};
    __syncthreads();
    if (has) { issue_k(F, cur); build_table(F, cur, MB2); load_q(F, cur, qr); }
    const int m4 = r32 & 3;
    const LAS unsigned char* tb = lds + TBL_OFF + m4 * (TBL_STRIDE * 4) + 4 * ((32 - r32 + 4 * hi) - ((4 - m4) & 3));
    const LAS unsigned char* kb_l = lds + K_OFF + r32 * 128;
    int kx[4];
#pragma unroll
    for (int d0 = 0; d0 < 4; ++d0) kx[d0] = ((2 * d0 + hi) ^ (r32 & 7)) * 16;
    const LAS unsigned char* vb_l = lds + V_OFF + ((lane >> 4) & 1) * 32 + (lane & 3) * 8 + (4 * hi + ((lane & 15) >> 2)) * 128;
    const int vsw = ((lane >> 3) & 1) * 64;
    const LAS unsigned char* negb = lds + NEG_OFF;
    LAS bf16* stg = (LAS bf16*)(lds + OST_OFF + w * 4096);
    LAS float* wsf = (LAS float*)(lds + WSF_OFF + w * 256);
    __syncthreads();
    for (int it = 0; has; ++it) {
        const int c = cur.c;
        issue_v(F, cur);
        bf16x8 pa[5][2]; float lsum = 0.f;
        f32x16 sc, sn;
#ifndef MK_REP_A
#define MK_REP_A 1
#endif
#ifndef MK_REP_B
#define MK_REP_B 1
#endif
#define QK_INIT(S, kb) do { const int k0_ = 32 * w + 32 * (kb); const LAS unsigned char* tbk_ = (c == 0 && k0_ < 128) ? negb : tb + 4 * 32 * (kb); \
            _Pragma("unroll") for (int q4 = 0; q4 < 4; ++q4) { const f32x4 t4 = *(const LAS f32x4*)(tbk_ + 4 * (8 * q4)); S[4 * q4] = t4[0]; S[4 * q4 + 1] = t4[1]; S[4 * q4 + 2] = t4[2]; S[4 * q4 + 3] = t4[3]; } } while (0)
#define K_FRAGS(KF, kb) do { const int k0_ = 32 * w + 32 * (kb); const LAS unsigned char* kp_ = kb_l + ((cur.base + (k0_ >> 6)) % 6) * 8192 + ((k0_ >> 5) & 1) * 4096; \
            _Pragma("unroll") for (int d0 = 0; d0 < 4; ++d0) KF[d0] = *(const LAS bf16x8*)(kp_ + kx[d0]); } while (0)
        bf16x8 kf[4];
#pragma unroll 1
        for (int repa = 0; repa < MK_REP_A; ++repa) { lsum = 0.f;
        QK_INIT(sc, 0); K_FRAGS(kf, 0);
#pragma unroll
        for (int d0 = 0; d0 < 4; ++d0) sc = __builtin_amdgcn_mfma_f32_32x32x16_bf16(kf[d0], qr[d0], sc, 0, 0, 0);
#pragma unroll
        for (int kb = 0; kb < 5; ++kb) {
            if (kb < 4) { QK_INIT(sn, kb + 1); K_FRAGS(kf, kb + 1); }
            unsigned pw[8];
            __builtin_amdgcn_sched_barrier(0);
#pragma unroll
            for (int g = 0; g < 4; ++g) {
                if (kb < 4) sn = __builtin_amdgcn_mfma_f32_32x32x16_bf16(kf[g], qr[g], sn, 0, 0, 0);
                const float e0 = __builtin_amdgcn_exp2f(sc[4 * g]), e1 = __builtin_amdgcn_exp2f(sc[4 * g + 1]), e2 = __builtin_amdgcn_exp2f(sc[4 * g + 2]), e3 = __builtin_amdgcn_exp2f(sc[4 * g + 3]);
                lsum += (e0 + e1) + (e2 + e3);
                pw[2 * g] = cvtpk(e0, e1); pw[2 * g + 1] = cvtpk(e2, e3);
                asm volatile("" : "+v"(pw[2 * g]), "+v"(pw[2 * g + 1]), "+v"(lsum));
                __builtin_amdgcn_sched_barrier(0);
            }
            pa[kb][0] = __builtin_bit_cast(bf16x8, (v4u){pw[0], pw[1], pw[2], pw[3]}); pa[kb][1] = __builtin_bit_cast(bf16x8, (v4u){pw[4], pw[5], pw[6], pw[7]});
            if (kb < 4) sc = sn;
        }
        }
#undef QK_INIT
#undef K_FRAGS
        __syncthreads();
        const bool has_next = item_decode<FINAL>(F, it + 1, nxt);
        if (has_next) { issue_k(F, nxt); build_table(F, nxt, MB2); load_q(F, nxt, qr); }
        const int qbase = 256 * c + 32 * w, b = cur.b, h = cur.h, d = cur.d, r = cur.r, ps = cur.ps;
        v4u pfa[4], pfb[4]; float pfl[4];
        if (FINAL) {
#pragma unroll
            for (int i = 0; i < 4; ++i) {
                const int rl = i * 8 + (lane >> 3), ch = lane & 7;
                const size_t row = (size_t)b * 8192 + (size_t)(r + d * (qbase + rl));
                pfa[i] = __builtin_nontemporal_load((const GAS v4u*)(F.PO + row * AW + h * 64 + ch * 8)); pfb[i] = __builtin_nontemporal_load((const GAS v4u*)(F.PO + ((size_t)M + row) * AW + h * 64 + ch * 8));
                pfl[i] = F.PL[row * NH + h] + F.PL[((size_t)M + row) * NH + h];
            }
        }
        f32x16 o0 = {}, o1 = {};
        s16x4 vA[8], vB[8];
#define V_READS(VR, kb) do { const int k0_ = 32 * w + 32 * (kb); const unsigned vp_ = (unsigned)(uintptr_t)(vb_l + ((cur.base + (k0_ >> 6)) % 6) * 8192 + ((k0_ >> 4) & 3) * 2048); \
            const unsigned vd0_ = vp_ + (unsigned)vsw, vd1_ = vp_ + (unsigned)(64 ^ vsw); \
            asm volatile("ds_read_b64_tr_b16 %0, %1" : "=&v"(VR[0]) : "v"(vd0_) : "memory"); asm volatile("ds_read_b64_tr_b16 %0, %1 offset:1024" : "=&v"(VR[1]) : "v"(vd0_) : "memory"); \
            asm volatile("ds_read_b64_tr_b16 %0, %1 offset:2048" : "=&v"(VR[2]) : "v"(vd0_) : "memory"); asm volatile("ds_read_b64_tr_b16 %0, %1 offset:3072" : "=&v"(VR[3]) : "v"(vd0_) : "memory"); \
            asm volatile("ds_read_b64_tr_b16 %0, %1" : "=&v"(VR[4]) : "v"(vd1_) : "memory"); asm volatile("ds_read_b64_tr_b16 %0, %1 offset:1024" : "=&v"(VR[5]) : "v"(vd1_) : "memory"); \
            asm volatile("ds_read_b64_tr_b16 %0, %1 offset:2048" : "=&v"(VR[6]) : "v"(vd1_) : "memory"); asm volatile("ds_read_b64_tr_b16 %0, %1 offset:3072" : "=&v"(VR[7]) : "v"(vd1_) : "memory"); } while (0)
#define V_WAIT(VR) do { asm volatile("s_waitcnt lgkmcnt(0)" : "+v"(VR[0]), "+v"(VR[1]), "+v"(VR[2]), "+v"(VR[3]), "+v"(VR[4]), "+v"(VR[5]), "+v"(VR[6]), "+v"(VR[7]) :: "memory"); __builtin_amdgcn_sched_barrier(0); } while (0)
#define VF(VR, i) ((bf16x8){VR[i][0], VR[i][1], VR[i][2], VR[i][3], VR[(i) + 1][0], VR[(i) + 1][1], VR[(i) + 1][2], VR[(i) + 1][3]})
#define PV_MMA(VR, kb) do { o0 = __builtin_amdgcn_mfma_f32_32x32x16_bf16(pa[kb][0], VF(VR, 0), o0, 0, 0, 0); o0 = __builtin_amdgcn_mfma_f32_32x32x16_bf16(pa[kb][1], VF(VR, 2), o0, 0, 0, 0); \
            o1 = __builtin_amdgcn_mfma_f32_32x32x16_bf16(pa[kb][0], VF(VR, 4), o1, 0, 0, 0); o1 = __builtin_amdgcn_mfma_f32_32x32x16_bf16(pa[kb][1], VF(VR, 6), o1, 0, 0, 0); } while (0)
#pragma unroll 1
        for (int repb = 0; repb < MK_REP_B; ++repb) { o0 = (f32x16){}; o1 = (f32x16){};
        V_READS(vA, 0); V_WAIT(vA);
        V_READS(vB, 1); PV_MMA(vA, 0); V_WAIT(vB);
        V_READS(vA, 2); PV_MMA(vB, 1); V_WAIT(vA);
        V_READS(vB, 3); PV_MMA(vA, 2); V_WAIT(vB);
        V_READS(vA, 4); PV_MMA(vB, 3); V_WAIT(vA);
        PV_MMA(vA, 4);
        }
#undef V_READS
#undef V_WAIT
#undef VF
#undef PV_MMA
        lsum += __shfl_xor(lsum, 32);
#pragma unroll
        for (int e = 0; e < 16; ++e) { const int orow = crow(e, hi); stg[orow * 64 + r32] = (bf16)f2bf(o0[e]); stg[orow * 64 + 32 + r32] = (bf16)f2bf(o1[e]); }
        if (hi == 0) wsf[r32] = lsum;
        LDS_WAIT(); asm volatile("" ::: "memory");
#pragma unroll
        for (int i = 0; i < 4; ++i) {
            const int rl = i * 8 + (lane >> 3), ch = lane & 7;
            const size_t row = (size_t)b * 8192 + (size_t)(r + d * (qbase + rl));
            const v4u ov = *(const LAS v4u*)(stg + rl * 64 + ch * 8);
            if (!FINAL) {
                *(GAS v4u*)(F.PO + ((size_t)ps * M + row) * AW + h * 64 + ch * 8) = ov;
                if (ch == 0) F.PL[((size_t)ps * M + row) * NH + h] = wsf[rl];
            } else {
                const v4u a = pfa[i], bq = pfb[i];
                const float l = wsf[rl] + pfl[i];
                const float rl_ = 1.0f / l;
                v4u o;
                o.x = pk2((bflo(ov.x) + bflo(a.x) + bflo(bq.x)) * rl_, (bfhi(ov.x) + bfhi(a.x) + bfhi(bq.x)) * rl_);
                o.y = pk2((bflo(ov.y) + bflo(a.y) + bflo(bq.y)) * rl_, (bfhi(ov.y) + bfhi(a.y) + bfhi(bq.y)) * rl_);
                o.z = pk2((bflo(ov.z) + bflo(a.z) + bflo(bq.z)) * rl_, (bfhi(ov.z) + bfhi(a.z) + bfhi(bq.z)) * rl_);
                o.w = pk2((bflo(ov.w) + bflo(a.w) + bflo(bq.w)) * rl_, (bfhi(ov.w) + bfhi(a.w) + bfhi(bq.w)) * rl_);
                *(GAS v4u*)(F.MIX + pg8::tiled_off((int)row, PW + h * 64 + ch * 8, 16)) = o;
            }
        }
        cur = nxt; has = has_next;
        if (has) { asm volatile("s_waitcnt vmcnt(%0) lgkmcnt(0)" :: "n"(FINAL ? 4 : 8) : "memory"); __builtin_amdgcn_s_barrier(); asm volatile("" ::: "memory"); }
    }
    __syncthreads();
}

__device__ __forceinline__ void pool_item(Frame& F, int item) {
    const int lane = F.lane, g = lane >> 4, W = 2 << g;
    const int row0 = item * 128 + F.wave * 16, t0 = row0 & 8191;
    const bf16* Up = F.U + (size_t)row0 * PW + lane * 8;
    const bool seq0 = (t0 == 0);
    const float rw = g == 0 ? 0.5f : (g == 1 ? 0.25f : (g == 2 ? 0.125f : 0.0625f));
    const v4u z4 = (v4u){0u, 0u, 0u, 0u};
    v4u ini[16], nw[8], od[8];
#pragma unroll
    for (int i = 1; i <= 16; ++i) ini[i - 1] = (i <= W && !seq0) ? *(const GAS v4u*)(Up - (long)i * PW) : z4;
#pragma unroll
    for (int k = 0; k < 8; ++k) { nw[k] = *(const GAS v4u*)(Up + (long)k * PW); od[k] = (!seq0 || k >= W) ? *(const GAS v4u*)(Up + (long)(k - W) * PW) : z4; }
    float s[8];
#pragma unroll
    for (int j = 0; j < 8; ++j) s[j] = 0.f;
#pragma unroll
    for (int i = 0; i < 16; ++i) {
        s[0] += bflo(ini[i].x); s[1] += bfhi(ini[i].x); s[2] += bflo(ini[i].y); s[3] += bfhi(ini[i].y); s[4] += bflo(ini[i].z); s[5] += bfhi(ini[i].z); s[6] += bflo(ini[i].w); s[7] += bfhi(ini[i].w);
    }
#pragma unroll
    for (int half = 0; half < 2; ++half) {
        v4u nw2[8], od2[8];
        if (half == 0) {
#pragma unroll
            for (int k = 0; k < 8; ++k) { nw2[k] = *(const GAS v4u*)(Up + (long)(k + 8) * PW); od2[k] = (!seq0 || k + 8 >= W) ? *(const GAS v4u*)(Up + (long)(k + 8 - W) * PW) : z4; }
        }
#pragma unroll
        for (int k = 0; k < 8; ++k) {
            const v4u a = nw[k], o = od[k];
            const float u0 = bflo(a.x), u1 = bfhi(a.x), u2 = bflo(a.y), u3 = bfhi(a.y), u4 = bflo(a.z), u5 = bfhi(a.z), u6 = bflo(a.w), u7 = bfhi(a.w);
            s[0] += u0 - bflo(o.x); s[1] += u1 - bfhi(o.x); s[2] += u2 - bflo(o.y); s[3] += u3 - bfhi(o.y); s[4] += u4 - bflo(o.z); s[5] += u5 - bfhi(o.z); s[6] += u6 - bflo(o.w); s[7] += u7 - bfhi(o.w);
            float rc = rw;
            if (seq0) { const int t = half * 8 + k, cnt = (t + 1 < W) ? t + 1 : W; rc = 1.0f / (float)cnt; }
            v4u ov; ov.x = cvtpk(s[0] * rc - u0, s[1] * rc - u1); ov.y = cvtpk(s[2] * rc - u2, s[3] * rc - u3); ov.z = cvtpk(s[4] * rc - u4, s[5] * rc - u5); ov.w = cvtpk(s[6] * rc - u6, s[7] * rc - u7);
            *(GAS v4u*)(F.MIX + pg8::tiled_off(row0 + half * 8 + k, lane * 8, 16)) = ov;
        }
        if (half == 0) {
#pragma unroll
            for (int k = 0; k < 8; ++k) { nw[k] = nw2[k]; od[k] = od2[k]; }
        }
    }
}

__device__ __forceinline__ void phase_2a(Frame& F) { const float MB2 = softmax_ref(F); attn_phase<false>(F, MB2); }
__device__ __forceinline__ void phase_2b(Frame& F) {
    const float MB2 = softmax_ref(F); attn_phase<true>(F, MB2);
    for (int it = F.vcu; it < M / 128; it += F.G) pool_item(F, it);
#if defined(MK_DUP_POOL)
    for (int it = F.vcu; it < M / 128; it += F.G) pool_item(F, it);
#endif
}
}

struct Args { const float* in[12]; float* out; unsigned char* ws; int ph_lo, ph_hi, li, pad; };
__global__ void __launch_bounds__(NWAVES * 64, 2) mk_fwd(Args args) {
    extern __shared__ __attribute__((aligned(16))) unsigned char lds[];
    Frame F;
    F.lds = (LAS unsigned char*)lds;
    F.MISC = (volatile LAS unsigned*)(F.lds + MISC_OFF);
    F.tid = threadIdx.x; F.lane = F.tid & 63; F.wave = __builtin_amdgcn_readfirstlane(F.tid >> 6);
    F.G = gridDim.x; { const int bx = blockIdx.x; F.vcu = (F.G % 8 == 0) ? (bx % 8) * (F.G / 8) + bx / 8 : bx; }
    unsigned char* ws = args.ws;
    F.ctl = (gu32*)(ws + WS_CTL);
    F.x = args.in[0]; F.g1 = args.in[1]; F.w_in = args.in[2]; F.pool_w = args.in[3]; F.pool_s = args.in[4]; F.qg = args.in[5]; F.kg = args.in[6]; F.rel_bias = args.in[7];
    F.w_out = args.in[8]; F.g2 = args.in[9]; F.w_up = args.in[10]; F.w_dn = args.in[11]; F.out = args.out;
    F.Win_t = (bf16*)(ws + WS_WIN); F.Wout_t = (bf16*)(ws + WS_WOUT); F.Wup_t = (bf16*)(ws + WS_WUP); F.Wdn_t = (bf16*)(ws + WS_WDN);
    F.XN = (bf16*)(ws + WS_XN); F.U = (bf16*)(ws + WS_U); F.Q = (bf16*)(ws + WS_Q); F.K = (bf16*)(ws + WS_K); F.V = (bf16*)(ws + WS_V); F.PO = (bf16*)(ws + WS_PO);
    F.MIX = (bf16*)(ws + WS_MIX); F.HB = (bf16*)(ws + WS_HB); F.FFB = (bf16*)(ws + WS_FF); F.RSS = (float*)(ws + WS_RSS); F.PL = (float*)(ws + WS_PL); F.RN1 = (float*)(ws + WS_RN1);
    for (int u = F.tid; u < (LDS_BYTES - LDSCTL_OFF) / 4; u += NWAVES * 64) ((LAS unsigned*)(F.lds + LDSCTL_OFF))[u] = 0u;
    __syncthreads();
    XcdBarrier bar; bar.bar = (unsigned*)(F.ctl + CW_BAR); bar.x = 0; bar.st = nullptr;
    if (!MK_PER_PHASE) bar = xcd_barrier_post((unsigned*)(F.ctl + CW_BAR), F.MISC + 8);
    const int lo = args.ph_lo, hi = args.ph_hi;
#define IN(k) (lo <= (k) && (k) < hi)
#ifndef MK_DUP_PHASE
#define MK_DUP_PHASE (-1)
#endif
#define BOTH(k) (IN(k) && IN((k) + 1))
#define GRID_BAR() do { if (!MK_PER_PHASE) xcd_barrier(bar); } while (0)

    if (IN(0)) { p0_prologue(F); if (BOTH(0)) GRID_BAR(); }
#if MK_DUP_PHASE == 0
    p0_prologue(F); GRID_BAR();
#endif
#define RUN_P1() do { pg8::Gemm g{F.XN, F.Win_t, M, NIN, D}; pg8::StaticOrder S; S.init(M, NIN, F.G, (int)blockIdx.x); \
        pg8::EpiInProj E{F.U, F.Q, F.K, F.V, F.qg, F.kg}; \
        pg8::gemm_phase<pg8::EpiInProj, pg8::StaticOrder, true, true, true, MK_P1_AUXA>(F.lds + RING_OFF, g, S, E); } while (0)
#define RUN_P4() do { pg8::Gemm g{F.MIX, F.Wout_t, M, D, D}; pg8::StaticOrder S; S.init(M, D, F.G, (int)blockIdx.x); \
        pg8::EpiOut E{F.XN, F.RN1, F.HB, F.RSS}; \
        pg8::gemm_phase<pg8::EpiOut, pg8::StaticOrder, true, true, true, MK_P4_AUXA>(F.lds + RING_OFF, g, S, E); } while (0)
#ifndef MK_MLP_PARTS
#define MK_MLP_PARTS 1
#endif
#define MH (M / MK_MLP_PARTS)
#ifndef MK_P6_AUXA
#define MK_P6_AUXA 2
#endif
#ifndef MK_P6_AUXB
#define MK_P6_AUXB 0
#endif
#ifndef MK_P4_AUXA
#define MK_P4_AUXA 0
#endif
#ifndef MK_P5_AUXA
#define MK_P5_AUXA 0
#endif
#ifndef MK_P1_AUXA
#define MK_P1_AUXA 0
#endif
#define RUN_P5(hf) do { pg8::Gemm g{F.HB + (size_t)(hf) * MH * D, F.Wup_t, MH, FF, D}; pg8::StaticOrder S; S.init(MH, FF, F.G, (int)blockIdx.x); \
        pg8::EpiUp E{F.FFB + (size_t)(hf) * MH * FF}; \
        pg8::gemm_phase<pg8::EpiUp, pg8::StaticOrder, true, true, true, MK_P5_AUXA>(F.lds + RING_OFF, g, S, E); } while (0)
#define RUN_P6(hf) do { pg8::Gemm g{F.FFB + (size_t)(hf) * MH * FF, F.Wdn_t, MH, D, FF}; pg8::StaticOrder S; S.init(MH, D, F.G, (int)blockIdx.x); \
        pg8::EpiDown E{F.HB + (size_t)(hf) * MH * D, F.RSS + (size_t)(hf) * MH * 16, F.out + (size_t)(hf) * MH * D}; \
        pg8::gemm_phase<pg8::EpiDown, pg8::StaticOrder, true, true, true, MK_P6_AUXA, MK_P6_AUXB>(F.lds + RING_OFF, g, S, E); } while (0)
    if (IN(1)) { RUN_P1(); if (BOTH(1)) GRID_BAR(); }
#if defined(MK_EXTRA_BARS)
    for (int eb = 0; eb < 16; ++eb) GRID_BAR();
#endif
#if MK_DUP_PHASE == 1
    RUN_P1(); GRID_BAR();
#endif
    if (IN(2)) { mixer::phase_2a(F); if (BOTH(2)) GRID_BAR(); }
#if MK_DUP_PHASE == 2
    mixer::phase_2a(F); GRID_BAR();
#endif
    if (IN(3)) { mixer::phase_2b(F); if (BOTH(3)) GRID_BAR(); }
#if MK_DUP_PHASE == 3
    mixer::phase_2b(F); GRID_BAR();
#endif
    if (IN(4)) { RUN_P4(); if (BOTH(4)) GRID_BAR(); }
#if MK_DUP_PHASE == 4
    RUN_P4(); GRID_BAR();
#endif
    if (IN(5)) { RUN_P5(0); if (BOTH(5)) GRID_BAR(); }
#if MK_DUP_PHASE == 5
    RUN_P5(0); GRID_BAR();
#endif
    if (IN(6)) { RUN_P6(0); if (BOTH(6) && MK_PER_PHASE) GRID_BAR(); }
#if MK_DUP_PHASE == 6
    RUN_P6(0); GRID_BAR();
#endif
#if MK_MLP_PARTS == 2
    if (IN(7)) { RUN_P5(1); if (BOTH(7)) GRID_BAR(); }
    if (IN(8)) { RUN_P6(1); }
#endif
#undef IN
#undef BOTH
#undef GRID_BAR
}

extern "C" void kernel_launch(void* const* d_in, const int* in_sizes, int n_in, void* d_out, int out_size, void* d_ws, size_t ws_size, hipStream_t stream) {
    static int grid = 0;
    if (grid == 0) {
        if (n_in != 12 || in_sizes[0] != M * D || out_size != M * D || ws_size < WS_END) { fprintf(stderr, "kernel_launch: unexpected shapes (n_in %d, in0 %d, out %d, ws %zu); nothing launched\n", n_in, n_in > 0 ? in_sizes[0] : -1, out_size, ws_size); grid = -1; return; }
        int dev = 0, cus = 0;
        if (hipGetDevice(&dev) != hipSuccess || hipDeviceGetAttribute(&cus, hipDeviceAttributeMultiprocessorCount, dev) != hipSuccess) { grid = -1; return; }
        if (hipFuncSetAttribute((const void*)mk_fwd, hipFuncAttributeMaxDynamicSharedMemorySize, LDS_BYTES) != hipSuccess) { fprintf(stderr, "kernel_launch: hipFuncSetAttribute failed\n"); grid = -1; return; }
        int per_cu = 0;
        if (hipOccupancyMaxActiveBlocksPerMultiprocessor(&per_cu, (const void*)mk_fwd, NWAVES * 64, LDS_BYTES) != hipSuccess || per_cu < 1) fprintf(stderr, "kernel_launch: occupancy query says %d\n", per_cu);
        (void)hipGetLastError();
        grid = cus;
    }
    if (grid < 0) return;
    if (hipMemsetAsync((char*)d_ws + WS_CTL, 0, 65536, stream) != hipSuccess) return;
    Args a{};
    for (int i = 0; i < 12; ++i) a.in[i] = (const float*)d_in[i];
    a.out = (float*)d_out; a.ws = (unsigned char*)d_ws;
#if MK_PER_PHASE
    for (int li = 0; li < NPHASE; ++li) { a.ph_lo = li; a.ph_hi = li + 1; a.li = li; hipLaunchKernelGGL(mk_fwd, dim3(grid), dim3(NWAVES * 64), LDS_BYTES, stream, a); }
#else
    a.ph_lo = 0; a.ph_hi = NPHASE; a.li = 0;
    hipLaunchKernelGGL(mk_fwd, dim3(grid), dim3(NWAVES * 64), LDS_BYTES, stream, a);
#if defined(MK_DUP_ALL)
    (void)hipMemsetAsync((char*)d_ws + WS_CTL, 0, CTL_ZERO_BYTES, stream);
    hipLaunchKernelGGL(mk_fwd, dim3(grid), dim3(NWAVES * 64), LDS_BYTES, stream, a);
#endif
#endif
}
```
